# Optimizing an MI355X kernel written in HIP

```python
import math
import jax, jax.numpy as jnp
from jax import lax
import numpy as np

D_MODEL = 1024
BATCH = 4
SEQ = 4096
DEPTH = 2

N_EVEN = (DEPTH + 1) // 2
N_ODD = DEPTH // 2
RMS_EPS = 1e-6
ROPE_THETA = 10000.0
Q_BLOCK = 128
GRID_W = 64

D_FF = 2816

A_HEADS = 4
A_DH = 64
A_QK = A_HEADS * 2 * A_DH
A_V = A_HEADS * 2 * A_DH

B_HEADS = 8
B_DH = 64
B_W = B_HEADS * B_DH
NA_ROWS = 8
NA_COLS = 16

C_WIDTH = 512
C_BLOCKS = 8
C_BW = C_WIDTH // C_BLOCKS
CONV_W = 4
RG_C = 8.0

D_HEADS = 8
D_NOPE = 64
D_ROPE = 32
D_VDIM = 64
D_Q_RANK = 256
D_KV_RANK = 128

EVEN_IN = 2 * A_QK + A_V + 3 * B_W
EVEN_MIX = A_V + B_W
ODD_IN = 2 * C_WIDTH + D_Q_RANK + D_KV_RANK + D_ROPE
ODD_MIX = C_WIDTH + D_HEADS * D_VDIM

kernel_name = "hybrid_diff_na_rglru_mla_encoder"


def rmsnorm(x, g):
    xf = x.astype(jnp.float32)
    y = xf * lax.rsqrt(jnp.mean(xf * xf, axis=-1, keepdims=True) + RMS_EPS)
    return (y * g.astype(jnp.float32)).astype(x.dtype)


def swiglu(x, wg, wu, wd):
    return (jax.nn.silu(x @ wg) * (x @ wu)) @ wd


def split_cols(x, sizes):
    idx, acc = [], 0
    for s in sizes[:-1]:
        acc += s
        idx.append(acc)
    return jnp.split(x, idx, axis=-1)


def rope_tables(seq, dim):
    inv = 1.0 / (ROPE_THETA ** (jnp.arange(0, dim, 2, dtype=jnp.float32) / dim))
    ang = jnp.arange(seq, dtype=jnp.float32)[:, None] * inv[None, :]
    return jnp.cos(ang), jnp.sin(ang)


def apply_rope(x, cos, sin):
    half = cos.shape[1]
    shape = (1, cos.shape[0]) + (1,) * (x.ndim - 3) + (half,)
    c = cos.reshape(shape).astype(x.dtype)
    s = sin.reshape(shape).astype(x.dtype)
    x1, x2 = x[..., :half], x[..., half:]
    return jnp.concatenate([x1 * c - x2 * s, x1 * s + x2 * c], axis=-1)


def blocked_attention(q, k, v, scale):
    B_, S, H, Dk = q.shape
    Dv = v.shape[-1]
    nb = S // Q_BLOCK
    qb = q.reshape(B_, nb, Q_BLOCK, H, Dk).swapaxes(0, 1)

    def block(qi):
        s = jnp.einsum('bqhd,bkhd->bhqk', qi, k).astype(jnp.float32) * scale
        p = jax.nn.softmax(s, axis=-1)
        return jnp.einsum('bhqk,bkhe->bqhe', p.astype(v.dtype), v)

    o = lax.map(block, qb)
    return o.swapaxes(0, 1).reshape(B_, S, H * Dv)


def diff_attention(q, k, v, lam, subln_g, lam_init):
    B_, S, H = q.shape[:3]
    nb = S // Q_BLOCK
    scale = A_DH ** -0.5
    qb = q.reshape(B_, nb, Q_BLOCK, H, 2, A_DH).swapaxes(0, 1)

    def block(qi):
        s = jnp.einsum('bqhmd,bkhmd->bhmqk', qi, k).astype(jnp.float32) * scale
        p = jax.nn.softmax(s, axis=-1)
        w = p[:, :, 0] - lam * p[:, :, 1]
        return jnp.einsum('bhqk,bkhe->bqhe', w.astype(v.dtype), v)

    o = lax.map(block, qb).swapaxes(0, 1).reshape(B_, S, H, 2 * A_DH)
    o = rmsnorm(o, subln_g) * (1.0 - lam_init)
    return o.reshape(B_, S, H * 2 * A_DH)


def neighbourhood_attention(q, k, v, rpb):
    B_, S, H, dh = q.shape
    rows = S // GRID_W
    wr = min(NA_ROWS, rows)
    wc = NA_COLS
    r = jnp.arange(rows)
    r0 = jnp.clip(r - wr // 2, 0, rows - wr)
    key_rows = r0[:, None] + jnp.arange(wr)[None, :]
    c = jnp.arange(GRID_W)
    c0 = jnp.clip(c - wc // 2, 0, GRID_W - wc)
    col_in = (c[None, :] >= c0[:, None]) & (c[None, :] < c0[:, None] + wc)
    qg = q.reshape(B_, rows, GRID_W, H, dh)
    kg = k.reshape(B_, rows, GRID_W, H, dh)[:, key_rows]
    vg = v.reshape(B_, rows, GRID_W, H, dh)[:, key_rows]
    s = jnp.einsum('brqhd,brjkhd->bhrqjk', qg, kg).astype(jnp.float32) * (dh ** -0.5)
    dr = key_rows - r[:, None]
    dc = jnp.clip(c[None, :] - c[:, None], -(wc - 1), wc - 1)
    idx_r = (dr + NA_ROWS - 1)[:, None, :, None]
    idx_c = (dc + NA_COLS - 1)[None, :, None, :]
    bias = rpb.astype(jnp.float32)[:, idx_r, idx_c]
    s = jnp.where(col_in[:, None, :], s + bias[None], -jnp.inf)
    sh = s.shape
    p = jax.nn.softmax(s.reshape(sh[:4] + (wr * GRID_W,)), axis=-1).reshape(sh)
    o = jnp.einsum('bhrqjk,brjkhd->brqhd', p.astype(v.dtype), vg)
    return o.reshape(B_, S, H * dh)


def centred_conv(x, w, b):
    S = x.shape[1]
    lp = (CONV_W - 1) // 2
    rp = CONV_W - 1 - lp
    xp = jnp.pad(x, ((0, 0), (lp, rp), (0, 0)))
    return sum(xp[:, j:j + S] * w[j] for j in range(CONV_W)) + b


def rg_lru(x, w_a, b_a, w_x, b_x, lam, reverse):
    B_, S, C = x.shape
    xb = x.reshape(B_, S, C_BLOCKS, C_BW)
    r_t = jax.nn.sigmoid((jnp.einsum('bsnc,ncd->bsnd', xb, w_a).reshape(B_, S, C) + b_a).astype(jnp.float32))
    i_t = jax.nn.sigmoid((jnp.einsum('bsnc,ncd->bsnd', xb, w_x).reshape(B_, S, C) + b_x).astype(jnp.float32))
    log_a = -RG_C * r_t * jax.nn.softplus(-lam.astype(jnp.float32))
    a = jnp.exp(log_a)
    mult = jnp.sqrt(-jnp.expm1(2.0 * log_a))
    first = jnp.arange(S) == (S - 1 if reverse else 0)
    mult = jnp.where(first[None, :, None], 1.0, mult)
    bterm = mult * i_t * x.astype(jnp.float32)

    def comb(l, rr):
        a_l, b_l = l
        a_r, b_r = rr
        return a_l * a_r, a_r * b_l + b_r

    _, h = lax.associative_scan(comb, (a, bterm), reverse=reverse, axis=1)
    return h


def mla_attention(cq, ckv, kr, gq, gkv, wuq, wukv, cos, sin):
    B_, S, _ = cq.shape
    q = (rmsnorm(cq, gq) @ wuq).reshape(B_, S, D_HEADS, D_NOPE + D_ROPE)
    q = jnp.concatenate([q[..., :D_NOPE], apply_rope(q[..., D_NOPE:], cos, sin)], axis=-1)
    kv = (rmsnorm(ckv, gkv) @ wukv).reshape(B_, S, D_HEADS, D_NOPE + D_VDIM)
    k_pe = apply_rope(kr[:, :, None, :], cos, sin)
    k = jnp.concatenate([kv[..., :D_NOPE], jnp.broadcast_to(k_pe, (B_, S, D_HEADS, D_ROPE))], axis=-1)
    v = kv[..., D_NOPE:]
    return blocked_attention(q, k, v, (D_NOPE + D_ROPE) ** -0.5)


def even_mixer(h, w_in, w_out, lam_vec, subln_g, rpb, lam_init, cos, sin):
    B_, S, _ = h.shape
    qa, ka, va, qb, kb, vb = split_cols(h @ w_in, [A_QK, A_QK, A_V, B_W, B_W, B_W])
    qa = apply_rope(qa.reshape(B_, S, 2 * A_HEADS, A_DH), cos, sin).reshape(B_, S, A_HEADS, 2, A_DH)
    ka = apply_rope(ka.reshape(B_, S, 2 * A_HEADS, A_DH), cos, sin).reshape(B_, S, A_HEADS, 2, A_DH)
    lf = lam_vec.astype(jnp.float32)
    lam = jnp.exp(jnp.sum(lf[0] * lf[1])) - jnp.exp(jnp.sum(lf[2] * lf[3])) + lam_init
    oa = diff_attention(qa, ka, va.reshape(B_, S, A_HEADS, 2 * A_DH), lam, subln_g, lam_init)
    ob = neighbourhood_attention(qb.reshape(B_, S, B_HEADS, B_DH), kb.reshape(B_, S, B_HEADS, B_DH),
                                 vb.reshape(B_, S, B_HEADS, B_DH), rpb)
    return jnp.concatenate([oa, ob], axis=-1) @ w_out


def odd_mixer(h, w_in, w_out, conv_w, conv_b, rg_wa, rg_ba, rg_wx, rg_bx, rg_lam,
              gq, gkv, wuq, wukv, cos, sin):
    xc, gc, cq, ckv, kr = split_cols(h @ w_in, [C_WIDTH, C_WIDTH, D_Q_RANK, D_KV_RANK, D_ROPE])
    u = centred_conv(xc, conv_w, conv_b)
    hr = (rg_lru(u, rg_wa[0], rg_ba[0], rg_wx[0], rg_bx[0], rg_lam[0], False)
          + rg_lru(u, rg_wa[1], rg_ba[1], rg_wx[1], rg_bx[1], rg_lam[1], True))
    oc = jax.nn.gelu(gc) * hr.astype(h.dtype)
    od = mla_attention(cq, ckv, kr, gq, gkv, wuq, wukv, cos, sin)
    return jnp.concatenate([oc, od], axis=-1) @ w_out


def setup_inputs(seed: int = 0) -> dict:
    key = jax.random.key(seed)
    ks = iter(jax.random.split(key, 40))

    def nrm(shape, scale):
        return jax.random.normal(next(ks), shape, jnp.float32) * scale

    def gain(shape):
        return 1.0 + nrm(shape, 0.02)

    u = jax.random.uniform(next(ks), (N_ODD, 2, C_WIDTH), jnp.float32, 0.9, 0.999)
    a0 = u ** (1.0 / RG_C)
    return {
        "x": nrm((BATCH, SEQ, D_MODEL), 1.0),
        "ffn1_norm": gain((DEPTH, D_MODEL)),
        "ffn1_wg": nrm((DEPTH, D_MODEL, D_FF), D_MODEL ** -0.5),
        "ffn1_wu": nrm((DEPTH, D_MODEL, D_FF), D_MODEL ** -0.5),
        "ffn1_wd": nrm((DEPTH, D_FF, D_MODEL), D_FF ** -0.5),
        "mix_norm": gain((DEPTH, D_MODEL)),
        "ffn2_norm": gain((DEPTH, D_MODEL)),
        "ffn2_wg": nrm((DEPTH, D_MODEL, D_FF), D_MODEL ** -0.5),
        "ffn2_wu": nrm((DEPTH, D_MODEL, D_FF), D_MODEL ** -0.5),
        "ffn2_wd": nrm((DEPTH, D_FF, D_MODEL), D_FF ** -0.5),
        "final_norm": gain((D_MODEL,)),
        "ev_w_in": nrm((N_EVEN, D_MODEL, EVEN_IN), D_MODEL ** -0.5),
        "ev_w_out": nrm((N_EVEN, EVEN_MIX, D_MODEL), EVEN_MIX ** -0.5),
        "diff_lam": nrm((N_EVEN, 4, A_DH), 0.1),
        "diff_subln": gain((N_EVEN, 2 * A_DH)),
        "na_rpb": nrm((N_EVEN, B_HEADS, 2 * NA_ROWS - 1, 2 * NA_COLS - 1), 0.02),
        "od_w_in": nrm((N_ODD, D_MODEL, ODD_IN), D_MODEL ** -0.5),
        "od_w_out": nrm((N_ODD, ODD_MIX, D_MODEL), ODD_MIX ** -0.5),
        "conv_w": nrm((N_ODD, CONV_W, C_WIDTH), CONV_W ** -0.5),
        "conv_b": nrm((N_ODD, C_WIDTH), 0.01),
        "rg_wa": nrm((N_ODD, 2, C_BLOCKS, C_BW, C_BW), C_BW ** -0.5),
        "rg_ba": nrm((N_ODD, 2, C_WIDTH), 0.01),
        "rg_wx": nrm((N_ODD, 2, C_BLOCKS, C_BW, C_BW), C_BW ** -0.5),
        "rg_bx": nrm((N_ODD, 2, C_WIDTH), 0.01),
        "rg_lam": jnp.log(a0) - jnp.log1p(-a0),
        "mla_gq": gain((N_ODD, D_Q_RANK)),
        "mla_gkv": gain((N_ODD, D_KV_RANK)),
        "mla_wuq": nrm((N_ODD, D_Q_RANK, D_HEADS * (D_NOPE + D_ROPE)), D_Q_RANK ** -0.5),
        "mla_wukv": nrm((N_ODD, D_KV_RANK, D_HEADS * (D_NOPE + D_VDIM)), D_KV_RANK ** -0.5),
    }


def reference(x, ffn1_norm, ffn1_wg, ffn1_wu, ffn1_wd, mix_norm, ffn2_norm, ffn2_wg, ffn2_wu,
              ffn2_wd, final_norm, ev_w_in, ev_w_out, diff_lam, diff_subln, na_rpb, od_w_in,
              od_w_out, conv_w, conv_b, rg_wa, rg_ba, rg_wx, rg_bx, rg_lam, mla_gq, mla_gkv,
              mla_wuq, mla_wukv):
    S = x.shape[1]
    cos_a, sin_a = rope_tables(S, A_DH)
    cos_d, sin_d = rope_tables(S, D_ROPE)
    for l in range(DEPTH):
        x = x + 0.5 * swiglu(rmsnorm(x, ffn1_norm[l]), ffn1_wg[l], ffn1_wu[l], ffn1_wd[l])
        h = rmsnorm(x, mix_norm[l])
        if l % 2 == 0:
            i = l // 2
            lam_init = 0.8 - 0.6 * math.exp(-0.3 * l)
            x = x + even_mixer(h, ev_w_in[i], ev_w_out[i], diff_lam[i], diff_subln[i], na_rpb[i],
                               lam_init, cos_a, sin_a)
        else:
            i = l // 2
            x = x + odd_mixer(h, od_w_in[i], od_w_out[i], conv_w[i], conv_b[i], rg_wa[i], rg_ba[i],
                              rg_wx[i], rg_bx[i], rg_lam[i], mla_gq[i], mla_gkv[i], mla_wuq[i],
                              mla_wukv[i], cos_d, sin_d)
        x = x + 0.5 * swiglu(rmsnorm(x, ffn2_norm[l]), ffn2_wg[l], ffn2_wu[l], ffn2_wd[l])
    return rmsnorm(x, final_norm)
```

```cpp
#include <hip/hip_runtime.h>
#include <hip/hip_bf16.h>
#include <cstdio>
#include <cstdint>

#ifndef MK_ONE_LAUNCH
#define MK_ONE_LAUNCH 1
#endif

#define LAS __attribute__((address_space(3)))
#define GAS __attribute__((address_space(1)))
typedef unsigned short bf16_t;
typedef short bf16x8 __attribute__((ext_vector_type(8)));
typedef short s16x4 __attribute__((ext_vector_type(4)));
typedef float f32x2 __attribute__((ext_vector_type(2)));
typedef float f32x4 __attribute__((ext_vector_type(4)));
typedef float f32x16 __attribute__((ext_vector_type(16)));
typedef unsigned u32x2 __attribute__((ext_vector_type(2)));
typedef unsigned u32x4 __attribute__((ext_vector_type(4)));

constexpr int BATCH = 4, SEQ = 4096, DM = 1024, FF = 2816, M = BATCH * SEQ;
constexpr int EVEN_IN = 3072, ODD_IN = 1440, ODD_INP = 1536;
constexpr float RMS_EPS = 1e-6f;
constexpr float LOG2E = 1.4426950408889634f;
constexpr float QS64 = 0.125f * LOG2E;
constexpr float QS96 = 0.10206207261596577f * LOG2E;

constexpr size_t MiB = 1u << 20;
constexpr size_t WS_CTL = 0, CTL_ZERO_BYTES = 32 * 1024;
constexpr size_t WS_SSQ16 = 1 * MiB;
constexpr size_t WS_SSQCQ = 2 * MiB;
constexpr size_t WS_SSQCKV = 2 * MiB + 256 * 1024;
constexpr size_t WS_COSA = 2 * MiB + 512 * 1024;
constexpr size_t WS_SINA = 3 * MiB;
constexpr size_t WS_COSD = 3 * MiB + 512 * 1024;
constexpr size_t WS_SIND = 3 * MiB + 768 * 1024;
constexpr size_t WS_RGW = 4 * MiB;
constexpr size_t WS_SPT = 4 * MiB + 256 * 1024;
constexpr size_t WS_SUM = 5 * MiB;
constexpr size_t WS_W = 8 * MiB;
constexpr size_t SZ_WGU = (size_t)2 * FF * DM * 2, SZ_WD = (size_t)DM * FF * 2;
constexpr size_t WS_WGU = WS_W;
constexpr size_t WS_WD = WS_WGU + 4 * SZ_WGU;
constexpr size_t WS_EVIN = WS_WD + 4 * SZ_WD;
constexpr size_t WS_EVOUT = WS_EVIN + (size_t)EVEN_IN * DM * 2;
constexpr size_t WS_ODIN = WS_EVOUT + (size_t)DM * DM * 2;
constexpr size_t WS_ODOUT = WS_ODIN + (size_t)ODD_INP * DM * 2;
constexpr size_t WS_WUQ = WS_ODOUT + (size_t)DM * DM * 2;
constexpr size_t WS_WUKV = WS_WUQ + (size_t)768 * 256 * 2;
constexpr size_t WS_WEND = WS_WUKV + (size_t)1024 * 256 * 2;
constexpr size_t WS_XB = 88 * MiB;
constexpr size_t WS_BIG = 120 * MiB;
constexpr size_t WS_H = WS_BIG;
constexpr size_t WS_QKV = WS_BIG;
constexpr size_t WS_MIX = WS_BIG + 96 * MiB;
constexpr size_t WS_OD = WS_BIG;
constexpr size_t WS_KF = WS_BIG + 48 * MiB;
constexpr size_t WS_VM = WS_BIG + 72 * MiB;
constexpr size_t WS_OA = WS_XB;
constexpr size_t WS_QM = WS_XB;
constexpr size_t WS_END = 256 * MiB;
static_assert(WS_WEND <= WS_XB, "weights fit");
static_assert(WS_H + (size_t)M * FF * 2 <= WS_END && WS_MIX + (size_t)M * DM * 2 <= WS_END && WS_VM + (size_t)M * 512 * 2 <= WS_MIX, "ws map");

constexpr int RING_BYTES = 131072;
constexpr int LDSCTL_OFF = RING_BYTES, MISC_OFF = LDSCTL_OFF + 320;
constexpr int LDS_BYTES = 147456;
constexpr int RS_MAXU = 12;
constexpr int RS_OFF = RING_BYTES + 1024;
static_assert(RS_OFF + RS_MAXU * 256 * 4 <= LDS_BYTES, "rs table");
constexpr int NWAVES = 8;

typedef _Float16 h16x8 __attribute__((ext_vector_type(8)));
__device__ __forceinline__ unsigned cvt_pk_bf16(float lo, float hi) { unsigned r; asm volatile("v_cvt_pk_f16_f32 %0, %1, %2" : "=v"(r) : "v"(lo), "v"(hi)); return r; }
__device__ __forceinline__ float bf2f(bf16_t b) { return (float)__builtin_bit_cast(_Float16, b); }
__device__ __forceinline__ unsigned f2bf(float f) { return (unsigned)__builtin_bit_cast(unsigned short, (_Float16)f); }
#define MFMA16(a, b, c) __builtin_amdgcn_mfma_f32_16x16x32_f16(__builtin_bit_cast(h16x8, (a)), __builtin_bit_cast(h16x8, (b)), (c), 0, 0, 0)
#define MFMA32(a, b, c) __builtin_amdgcn_mfma_f32_32x32x16_f16(__builtin_bit_cast(h16x8, (a)), __builtin_bit_cast(h16x8, (b)), (c), 0, 0, 0)
__device__ __forceinline__ float wave_sum(float v) {
#pragma unroll
    for (int o = 1; o < 64; o <<= 1) v += __shfl_xor(v, o);
    return v;
}
__device__ __forceinline__ float sum16(const float* p) {
    const f32x4 a = ((const f32x4*)p)[0], b = ((const f32x4*)p)[1], c = ((const f32x4*)p)[2], d = ((const f32x4*)p)[3];
    return ((a.x + a.y) + (a.z + a.w)) + ((b.x + b.y) + (b.z + b.w)) + ((c.x + c.y) + (c.z + c.w)) + ((d.x + d.y) + (d.z + d.w));
}
__device__ __forceinline__ float sum4(const float* p) { const f32x4 a = *(const f32x4*)p; return (a.x + a.y) + (a.z + a.w); }
__device__ __forceinline__ float fast_sigmoid(float x) { return __builtin_amdgcn_rcpf(1.0f + __builtin_amdgcn_exp2f(-x * LOG2E)); }

namespace pg8 {
constexpr int BM = 256, BK = 64, HALF = 128, HTB = HALF * BK * 2, STAGE_BYTES = 8 * HTB, NXCD = 8, WGM = 8;
__host__ __device__ __forceinline__ int lds_byte(int r, int c) { const int st = (r >> 4) * 2 + (c >> 5), rr = r & 15, cc = c & 31, ob = rr * 64 + cc * 2; return st * 1024 + (ob ^ (((ob >> 9) & 1) << 5)); }
__host__ __device__ __forceinline__ void stage_rc(int b, int& R, int& C) { const int st = b / 1024, sb = b % 1024, swz = sb ^ (((sb >> 9) & 1) << 5); R = (st >> 1) * 16 + swz / 64; C = (st & 1) * 32 + (swz % 64) / 2; }
__host__ __device__ __forceinline__ int perm32(int rho) { const int n = rho >> 4, i = rho & 15; return 8 * (i >> 2) + 4 * n + (i & 3); }

struct Unit { int pm, pn; };
struct Gemm { const bf16_t* A; const bf16_t* Bt; int lda, N, K; };
struct RsSpec { const float* src; int nper; float invn; };

struct StaticOrder {
    int nM, nN, nwg, G, c;
    __device__ void init(int M_, int N, int G_, int c_) { nM = M_ / BM; nN = N / BM; nwg = nM * nN; G = G_; c = c_; }
    __device__ bool next(int i, Unit& u) const {
        const long L = (long)i * G + c; if (L >= nwg) return false;
        int wgid = (int)L; { const int q = nwg / NXCD, r = nwg % NXCD, xcd = wgid % NXCD, off = wgid / NXCD; wgid = (xcd < r ? xcd * (q + 1) : r * (q + 1) + (xcd - r) * q) + off; }
        const int nig = WGM * nN, gid = wgid / nig, fm = gid * WGM, gsz = (nM - fm) < WGM ? (nM - fm) : WGM;
        u.pm = fm + ((wgid % nig) % gsz); u.pn = (wgid % nig) / gsz; return true;
    }
};

template <class Epi>
__device__ __forceinline__ void gemm_phase(LAS unsigned char* lds, const Gemm g, const StaticOrder& S, const Epi& E, const RsSpec rsp, const int tid) {
    const int wid = __builtin_amdgcn_readfirstlane(tid >> 6), lane = tid & 63, wr = wid >> 2, wc = wid & 3, fr = lane & 15, fq = lane >> 4;
    int K_ = g.K, lda_ = g.lda; asm volatile("" : "+s"(K_), "+s"(lda_));
    const int K = K_, nt = K / BK, lda = lda_;
    unsigned voffA[2], voffB[2];
#pragma unroll
    for (int i = 0; i < 2; ++i) { int R, C; stage_rc(tid * 16 + i * 8192, R, C); const int Rb = Epi::PERM ? ((R & ~31) + perm32(R & 31)) : R;
        voffA[i] = (unsigned)(R * lda + C) * 2u; voffB[i] = (unsigned)(Rb * K + C) * 2u; }
    const size_t kstep = (size_t)(BK * 2);
    const size_t hstepA = (size_t)HALF * lda * 2, hstepB = (size_t)HALF * K * 2;
    const size_t tstepA = 2 * hstepA, tstepB = 2 * hstepB;
    const unsigned ldsw = (unsigned)wid * 1024u;
    const int aoff = lds_byte(wr * 64 + fr, fq * 8), boff = lds_byte(wc * 32 + fr, fq * 8);
#define PG8_SA(b, h) (((b) * 2 + (h)) * HTB)
#define PG8_SB(b, h) ((4 + (b) * 2 + (h)) * HTB)
#define PG8_STAGE(bufoff, gbase, voff) do { _Pragma("unroll") for (int _i = 0; _i < 2; ++_i) \
        __builtin_amdgcn_global_load_lds((const unsigned*)((const char*)(gbase) + (voff)[_i]), (LAS unsigned*)(lds + (bufoff) + ldsw + _i * 8192), 16, 0, 0); } while (0)
#define PG8_LDA(dst, b, h) do { _Pragma("unroll") for (int m = 0; m < 4; ++m) _Pragma("unroll") for (int k = 0; k < 2; ++k) dst[m][k] = *(const LAS bf16x8*)(lds + PG8_SA(b, h) + aoff + m * 2048 + k * 1024); } while (0)
#define PG8_LDB(dst, b, h) do { _Pragma("unroll") for (int n = 0; n < 2; ++n) _Pragma("unroll") for (int k = 0; k < 2; ++k) dst[n][k] = *(const LAS bf16x8*)(lds + PG8_SB(b, h) + boff + n * 2048 + k * 1024); } while (0)
#define PG8_MMA(ai, bj, At, Bt) do { __builtin_amdgcn_s_setprio(1); _Pragma("unroll") for (int m = 0; m < 4; ++m) _Pragma("unroll") for (int n = 0; n < 2; ++n) _Pragma("unroll") for (int k = 0; k < 2; ++k) \
        acc[ai][bj][m][n] = MFMA16(Bt[n][k], At[m][k], acc[ai][bj][m][n]); __builtin_amdgcn_s_setprio(0); } while (0)
#define PG8_WAIT_V(n) asm volatile("s_waitcnt vmcnt(" #n ")" ::: "memory")
#define PG8_WAIT_L(n) asm volatile("s_waitcnt lgkmcnt(" #n ")" ::: "memory")
#define PG8_BAR __builtin_amdgcn_s_barrier()
#define PG8_SCHED __builtin_amdgcn_sched_barrier(0)
    Unit cur, nxt; int ui = 0;
    if (!S.next(0, cur)) return;
    f32x4 acc[2][2][4][2];
#pragma unroll
    for (int a = 0; a < 2; ++a)
#pragma unroll
        for (int b = 0; b < 2; ++b)
#pragma unroll
            for (int m = 0; m < 4; ++m)
#pragma unroll
                for (int n = 0; n < 2; ++n) acc[a][b][m][n] = (f32x4){0.f, 0.f, 0.f, 0.f};
    bf16x8 At[4][2], B0[2][2], B1[2][2];
    const char* cA = (const char*)g.A + (size_t)cur.pm * tstepA; const char* cB = (const char*)g.Bt + (size_t)cur.pn * tstepB;
    PG8_STAGE(PG8_SB(0, 0), cB, voffB); PG8_STAGE(PG8_SB(0, 1), cB + hstepB, voffB); PG8_STAGE(PG8_SA(0, 0), cA, voffA); PG8_STAGE(PG8_SA(0, 1), cA + hstepA, voffA);
    LAS float* RS = (LAS float*)(lds + RS_OFF);
    if (rsp.src) {
#pragma unroll 1
        for (int i = 0; i < RS_MAXU; ++i) { Unit u; if (!S.next(i, u)) break;
            if (tid < 256) { const float* p = rsp.src + (size_t)(u.pm * BM + tid) * rsp.nper;
                const float sm = (rsp.nper == 16) ? sum16(p) : sum4(p);
                RS[i * 256 + tid] = rsqrtf(sm * rsp.invn + RMS_EPS); } }
        __syncthreads();
    }
    if (wr == 1) PG8_BAR;
    PG8_WAIT_V(2); PG8_BAR;
    PG8_STAGE(PG8_SB(1, 0), cB + kstep, voffB); PG8_STAGE(PG8_SA(1, 0), cA + kstep, voffA); PG8_STAGE(PG8_SB(1, 1), cB + hstepB + kstep, voffB);
    PG8_WAIT_V(6); PG8_BAR;
    for (;;) {
        const bool has_next = S.next(ui + 1, nxt);
        const char* nA = has_next ? (const char*)g.A + (size_t)nxt.pm * tstepA : cA; const char* nB = has_next ? (const char*)g.Bt + (size_t)nxt.pn * tstepB : cB;
        for (int t = 0; t < nt; t += 2) {
            const bool last = (t == nt - 2);
            const char* a1 = cA + (size_t)(t + 1) * kstep;
            const char* a2 = last ? nA : cA + (size_t)(t + 2) * kstep; const char* b2 = last ? nB : cB + (size_t)(t + 2) * kstep;
            const char* a3 = a2 + kstep; const char* b3 = b2 + kstep;
            PG8_LDB(B0, 0, 0); PG8_LDB(B1, 0, 1); PG8_SCHED; PG8_LDA(At, 0, 0); PG8_STAGE(PG8_SA(1, 1), a1 + hstepA, voffA);
            PG8_WAIT_V(8); PG8_WAIT_L(0); PG8_BAR; PG8_MMA(0, 0, At, B0); PG8_MMA(0, 1, At, B1); PG8_BAR; PG8_SCHED;
            PG8_LDA(At, 0, 1); PG8_STAGE(PG8_SB(0, 0), b2, voffB); PG8_STAGE(PG8_SB(0, 1), b2 + hstepB, voffB); PG8_STAGE(PG8_SA(0, 0), a2, voffA);
            PG8_WAIT_V(8); PG8_WAIT_L(0); PG8_BAR; PG8_MMA(1, 0, At, B0); PG8_MMA(1, 1, At, B1); PG8_BAR; PG8_SCHED;
            PG8_LDB(B0, 1, 0); PG8_LDB(B1, 1, 1); PG8_SCHED; PG8_LDA(At, 1, 0); PG8_STAGE(PG8_SA(0, 1), a2 + hstepA, voffA);
            PG8_WAIT_V(8); PG8_WAIT_L(0); PG8_BAR; PG8_MMA(0, 0, At, B0); PG8_MMA(0, 1, At, B1); PG8_BAR; PG8_SCHED;
            PG8_LDA(At, 1, 1); PG8_STAGE(PG8_SB(1, 0), b3, voffB); PG8_STAGE(PG8_SB(1, 1), b3 + hstepB, voffB); PG8_STAGE(PG8_SA(1, 0), a3, voffA);
            PG8_WAIT_V(8); PG8_WAIT_L(0); PG8_BAR; PG8_MMA(1, 0, At, B0); PG8_MMA(1, 1, At, B1); PG8_BAR; PG8_SCHED;
        }
        if (wr == 0) PG8_BAR;
        E(acc, cur, wr, wc, fr, fq, RS + ui * 256);
        if (!has_next) break;
#pragma unroll
        for (int a = 0; a < 2; ++a)
#pragma unroll
            for (int b = 0; b < 2; ++b)
#pragma unroll
                for (int m = 0; m < 4; ++m)
#pragma unroll
                    for (int n = 0; n < 2; ++n) acc[a][b][m][n] = (f32x4){0.f, 0.f, 0.f, 0.f};
        cur = nxt; cA = nA; cB = nB; ++ui;
        if (wr == 1) PG8_BAR;
    }
    PG8_WAIT_V(0);
    PG8_BAR;
#undef PG8_SA
#undef PG8_SB
#undef PG8_STAGE
#undef PG8_LDA
#undef PG8_LDB
#undef PG8_MMA
#undef PG8_WAIT_V
#undef PG8_WAIT_L
#undef PG8_BAR
#undef PG8_SCHED
}

__device__ __forceinline__ u32x4 pack8(const f32x4 a, const f32x4 b) { u32x4 w; w.x = cvt_pk_bf16(a[0], a[1]); w.y = cvt_pk_bf16(a[2], a[3]); w.z = cvt_pk_bf16(b[0], b[1]); w.w = cvt_pk_bf16(b[2], b[3]); return w; }

struct EpiSwiglu {
    static constexpr bool PERM = true;
    bf16_t* H; const float* ssq;
    __device__ __forceinline__ void operator()(const f32x4 (&acc)[2][2][4][2], const Unit& u, int wr, int wc, int fr, int fq, const LAS float* rs) const {
        const int row0 = u.pm * BM + wr * 64 + fr, col0 = u.pn * 128 + wc * 32 + 8 * fq;
#pragma unroll
        for (int ai = 0; ai < 2; ++ai)
#pragma unroll
            for (int m = 0; m < 4; ++m) {
                const int row = row0 + ai * HALF + m * 16;
                const float rstd = rs[ai * HALF + wr * 64 + m * 16 + fr];
                f32x4 h[2];
#pragma unroll
                for (int n = 0; n < 2; ++n) {
                    const f32x4 gt = acc[ai][0][m][n] * rstd, up = acc[ai][1][m][n] * rstd;
#pragma unroll
                    for (int e = 0; e < 4; ++e) h[n][e] = gt[e] * fast_sigmoid(gt[e]) * up[e];
                }
                *(u32x4*)(H + (size_t)row * FF + col0) = pack8(h[0], h[1]);
            }
    }
};

struct EpiResid {
    static constexpr bool PERM = false;
    bf16_t* xb; float* ssq; float alpha;
    __device__ __forceinline__ void operator()(const f32x4 (&acc)[2][2][4][2], const Unit& u, int wr, int wc, int fr, int fq, const LAS float* rs) const {
        const int row0 = u.pm * BM + wr * 64 + fr, col0 = u.pn * BM + wc * 32 + 4 * fq;
#pragma unroll
        for (int ai = 0; ai < 2; ++ai)
#pragma unroll
            for (int m = 0; m < 4; ++m) {
                const int row = row0 + ai * HALF + m * 16; const size_t off = (size_t)row * DM + col0; float s = 0.f;
                u32x2 rv[2][2];
#pragma unroll
                for (int bj = 0; bj < 2; ++bj)
#pragma unroll
                    for (int n = 0; n < 2; ++n) rv[bj][n] = *(const u32x2*)(xb + off + bj * HALF + n * 16);
#pragma unroll
                for (int bj = 0; bj < 2; ++bj)
#pragma unroll
                    for (int n = 0; n < 2; ++n) {
                        const f32x4 r = {bf2f((bf16_t)(rv[bj][n].x & 0xffffu)), bf2f((bf16_t)(rv[bj][n].x >> 16)), bf2f((bf16_t)(rv[bj][n].y & 0xffffu)), bf2f((bf16_t)(rv[bj][n].y >> 16))};
                        const f32x4 o = r + acc[ai][bj][m][n] * alpha;
                        s += (o[0] * o[0] + o[1] * o[1]) + (o[2] * o[2] + o[3] * o[3]);
                        u32x2 w; w.x = cvt_pk_bf16(o[0], o[1]); w.y = cvt_pk_bf16(o[2], o[3]);
                        *(u32x2*)(xb + off + bj * HALF + n * 16) = w;
                    }
                s += __shfl_xor(s, 16); s += __shfl_xor(s, 32);
                if (fq == 0) ssq[(size_t)row * 16 + u.pn * 4 + wc] = s;
            }
    }
};

struct EpiInEven {
    static constexpr bool PERM = true;
    bf16_t* QKV; const float* ssq; const float* cosA; const float* sinA;
    __device__ __forceinline__ void operator()(const f32x4 (&acc)[2][2][4][2], const Unit& u, int wr, int wc, int fr, int fq, const LAS float* rs) const {
        const int row0 = u.pm * BM + wr * 64 + fr, pn = u.pn;
        const bool rope = pn < 4;
        const float sc = (pn < 2 || pn == 6 || pn == 7) ? QS64 : 1.0f;
#pragma unroll
        for (int ai = 0; ai < 2; ++ai)
#pragma unroll
            for (int m = 0; m < 4; ++m) {
                const int row = row0 + ai * HALF + m * 16;
                const float rsv = rs[ai * HALF + wr * 64 + m * 16 + fr] * sc;
                bf16_t* rowp = QKV + (size_t)row * EVEN_IN + pn * BM;
                if (rope) {
                    const int pos = row & (SEQ - 1);
                    const float* cp = cosA + pos * 32 + 8 * fq; const float* sp = sinA + pos * 32 + 8 * fq;
                    f32x4 o1[2], o2[2];
#pragma unroll
                    for (int n = 0; n < 2; ++n) {
                        const f32x4 c = *(const f32x4*)(cp + 4 * n), s = *(const f32x4*)(sp + 4 * n);
                        const f32x4 x1 = acc[ai][0][m][n] * rsv, x2 = acc[ai][1][m][n] * rsv;
                        o1[n] = x1 * c - x2 * s; o2[n] = x1 * s + x2 * c;
                    }
                    *(u32x4*)(rowp + 64 * wc + 8 * fq) = pack8(o1[0], o1[1]);
                    *(u32x4*)(rowp + 64 * wc + 32 + 8 * fq) = pack8(o2[0], o2[1]);
                } else {
#pragma unroll
                    for (int bj = 0; bj < 2; ++bj)
                        *(u32x4*)(rowp + bj * HALF + wc * 32 + 8 * fq) = pack8(acc[ai][bj][m][0] * rsv, acc[ai][bj][m][1] * rsv);
                }
            }
    }
};

struct EpiInOdd {
    static constexpr bool PERM = true;
    bf16_t* OD; const float* ssq; float* ssq_cq; float* ssq_ckv;
    __device__ __forceinline__ void operator()(const f32x4 (&acc)[2][2][4][2], const Unit& u, int wr, int wc, int fr, int fq, const LAS float* rs) const {
        const int row0 = u.pm * BM + wr * 64 + fr, pn = u.pn;
#pragma unroll
        for (int ai = 0; ai < 2; ++ai)
#pragma unroll
            for (int m = 0; m < 4; ++m) {
                const int row = row0 + ai * HALF + m * 16;
                const float rsv = rs[ai * HALF + wr * 64 + m * 16 + fr];
                bf16_t* rowp = OD + (size_t)row * ODD_INP + pn * BM;
                float s0 = 0.f, s1 = 0.f;
#pragma unroll
                for (int bj = 0; bj < 2; ++bj) {
                    const f32x4 a = acc[ai][bj][m][0] * rsv, b = acc[ai][bj][m][1] * rsv;
                    *(u32x4*)(rowp + bj * HALF + wc * 32 + 8 * fq) = pack8(a, b);
                    const float q = ((a[0] * a[0] + a[1] * a[1]) + (a[2] * a[2] + a[3] * a[3])) + ((b[0] * b[0] + b[1] * b[1]) + (b[2] * b[2] + b[3] * b[3]));
                    if (bj == 0) s0 = q; else s1 = q;
                }
                if (pn == 4 || pn == 5) {
                    float s = (pn == 4) ? (s0 + s1) : s0;
                    s += __shfl_xor(s, 16); s += __shfl_xor(s, 32);
                    if (fq == 0) { if (pn == 4) ssq_cq[(size_t)row * 4 + wc] = s; else ssq_ckv[(size_t)row * 4 + wc] = s; }
                }
            }
    }
};

struct EpiQup {
    static constexpr bool PERM = true;
    bf16_t* Qm; const float* ssq_cq; const float* cosD; const float* sinD;
    __device__ __forceinline__ void operator()(const f32x4 (&acc)[2][2][4][2], const Unit& u, int wr, int wc, int fr, int fq, const LAS float* rs) const {
        const int row0 = u.pm * BM + wr * 64 + fr, pn = u.pn;
#pragma unroll
        for (int ai = 0; ai < 2; ++ai)
#pragma unroll
            for (int m = 0; m < 4; ++m) {
                const int row = row0 + ai * HALF + m * 16;
                const float rsv = rs[ai * HALF + wr * 64 + m * 16 + fr] * QS96;
                bf16_t* rowp = Qm + (size_t)row * 768;
                if (pn == 2) {
                    const int pos = row & (SEQ - 1), head = 2 * wc + (fq >> 1), d0 = 8 * (fq & 1);
                    const float* cp = cosD + pos * 16 + d0; const float* sp = sinD + pos * 16 + d0;
                    f32x4 o1[2], o2[2];
#pragma unroll
                    for (int n = 0; n < 2; ++n) {
                        const f32x4 c = *(const f32x4*)(cp + 4 * n), s = *(const f32x4*)(sp + 4 * n);
                        const f32x4 x1 = acc[ai][0][m][n] * rsv, x2 = acc[ai][1][m][n] * rsv;
                        o1[n] = x1 * c - x2 * s; o2[n] = x1 * s + x2 * c;
                    }
                    *(u32x4*)(rowp + head * 96 + 64 + d0) = pack8(o1[0], o1[1]);
                    *(u32x4*)(rowp + head * 96 + 80 + d0) = pack8(o2[0], o2[1]);
                } else {
#pragma unroll
                    for (int bj = 0; bj < 2; ++bj) {
                        const int c = pn * BM + bj * HALF + wc * 32 + 8 * fq, h = c >> 6, d = c & 63;
                        *(u32x4*)(rowp + h * 96 + d) = pack8(acc[ai][bj][m][0] * rsv, acc[ai][bj][m][1] * rsv);
                    }
                }
            }
    }
};

struct EpiKVup {
    static constexpr bool PERM = true;
    bf16_t* Kf; bf16_t* Vm; const float* ssq_ckv;
    __device__ __forceinline__ void operator()(const f32x4 (&acc)[2][2][4][2], const Unit& u, int wr, int wc, int fr, int fq, const LAS float* rs) const {
        const int row0 = u.pm * BM + wr * 64 + fr, pn = u.pn;
#pragma unroll
        for (int ai = 0; ai < 2; ++ai)
#pragma unroll
            for (int m = 0; m < 4; ++m) {
                const int row = row0 + ai * HALF + m * 16;
                const float rsv = rs[ai * HALF + wr * 64 + m * 16 + fr];
#pragma unroll
                for (int bj = 0; bj < 2; ++bj) {
                    const int h = 2 * pn + bj, j = wc * 32 + 8 * fq;
                    bf16_t* dst = (wc < 2) ? (Kf + (size_t)row * 768 + h * 96 + j) : (Vm + (size_t)row * 512 + h * 64 + (j - 64));
                    *(u32x4*)dst = pack8(acc[ai][bj][m][0] * rsv, acc[ai][bj][m][1] * rsv);
                }
            }
    }
};
}

namespace att {
constexpr int NW = 8, QBLK = 32, KVBLK = 64;
constexpr float THR2 = 8.f;
#define SBAR() __builtin_amdgcn_sched_barrier(0)
__device__ __forceinline__ int crow(int r, int hi) { return (r & 3) + 8 * (r >> 2) + 4 * hi; }
template <int DK> struct KGeo { static constexpr int ROWB = DK * 2 + 16, BYTES = 64 * ROWB; };
template <int DV> struct VGeo { static constexpr int NCB = DV / 32, BYTES = 64 * DV * 2; };
template <int DK, int DV> struct Geo { static constexpr int KOFF = 2 * VGeo<DV>::BYTES, WSOFF = KOFF + 2 * KGeo<DK>::BYTES, RPBOFF = WSOFF + NW * 64 * 4, BYTES = RPBOFF + 2048; };

struct NAArgs { int qb; const LAS float* rpb; };

__device__ __forceinline__ void partialSM(f32x16& p0, f32x16& p1, float& m_reg, f32x16& negm, float& alpha, bool& first) {
    float pmax = p0[0];
#pragma unroll
    for (int r = 1; r < 16; ++r) pmax = fmaxf(pmax, p0[r]);
#pragma unroll
    for (int r = 0; r < 16; ++r) pmax = fmaxf(pmax, p1[r]);
    { auto rr = __builtin_amdgcn_permlane32_swap(__float_as_uint(pmax), __float_as_uint(pmax), false, false);
      pmax = fmaxf(__uint_as_float(rr[0]), __uint_as_float(rr[1])); }
    if (__builtin_expect(!first && __all(pmax <= THR2), 1)) { alpha = 1.f; }
    else {
        const float dl = first ? ((pmax == -INFINITY) ? 0.f : pmax) : fmaxf(pmax, 0.f);
        alpha = first ? 0.f : __builtin_amdgcn_exp2f(-dl); m_reg += dl; first = false;
#pragma unroll
        for (int r = 0; r < 16; ++r) { p0[r] = p0[r] - dl; p1[r] = p1[r] - dl; }
#pragma unroll
        for (int r = 0; r < 16; ++r) negm[r] = -m_reg;
        asm volatile("" : "+v"(negm));
    }
#pragma unroll
    for (int r = 0; r < 16; ++r) p0[r] = __builtin_amdgcn_exp2f(p0[r]);
}
__device__ __forceinline__ void finishSM(f32x16& p0, f32x16& p1, float alpha, float& l_reg, bf16x8& pa0, bf16x8& pa1, bf16x8& pa2, bf16x8& pa3) {
#pragma unroll
    for (int r = 0; r < 16; ++r) p1[r] = __builtin_amdgcn_exp2f(p1[r]);
    float ps = 0;
#pragma unroll
    for (int r = 0; r < 16; ++r) ps += p0[r];
#pragma unroll
    for (int r = 0; r < 16; ++r) ps += p1[r];
    { auto rr = __builtin_amdgcn_permlane32_swap(__float_as_uint(ps), __float_as_uint(ps), false, false);
      ps = __uint_as_float(rr[0]) + __uint_as_float(rr[1]); }
    l_reg = l_reg * alpha + ps;
#define PK4(P, BASE, OUT) do { unsigned a0 = cvt_pk_bf16(P[BASE + 0], P[BASE + 1]), a1 = cvt_pk_bf16(P[BASE + 2], P[BASE + 3]);   \
    unsigned b0 = cvt_pk_bf16(P[BASE + 4], P[BASE + 5]), b1 = cvt_pk_bf16(P[BASE + 6], P[BASE + 7]);                              \
    auto r0 = __builtin_amdgcn_permlane32_swap(a0, b0, false, false); auto r1 = __builtin_amdgcn_permlane32_swap(a1, b1, false, false); \
    u32x4 w = {r0[0], r1[0], r0[1], r1[1]}; OUT = __builtin_bit_cast(bf16x8, w); } while (0)
    PK4(p0, 0, pa0); PK4(p0, 8, pa1); PK4(p1, 0, pa2); PK4(p1, 8, pa3);
#undef PK4
}
template <int DK>
__device__ __forceinline__ void qkt(f32x16& p0, f32x16& p1, const LAS char* Ks, const bf16x8* qr, int r32, int hi, const f32x16& negm) {
    p0 = negm; p1 = negm;
#pragma unroll
    for (int d0 = 0; d0 < DK / 16; ++d0) { const int cb = (d0 * 16 + hi * 8) * 2;
        const bf16x8 b0 = *(const LAS bf16x8*)(Ks + r32 * KGeo<DK>::ROWB + cb);
        const bf16x8 b1 = *(const LAS bf16x8*)(Ks + (32 + r32) * KGeo<DK>::ROWB + cb);
        p0 = MFMA32(b0, qr[d0], p0);
        p1 = MFMA32(b1, qr[d0], p1); }
}
template <int DV> __device__ __forceinline__ int v_st(int k, int c) { const int kk = (k & ~0xC) | ((k & 4) << 1) | ((k & 8) >> 1); return ((kk >> 3) * VGeo<DV>::NCB + (c >> 5)) * 512 + ((kk & 7) * 32 + (c & 31)) * 2; }
__device__ __forceinline__ int v_rd_base(int lane) { return ((lane & 3) << 3) | (((lane >> 2) & 3) << 6) | (((lane >> 4) & 1) << 5) | (((lane >> 5) & 1) << 8); }
template <int DV> constexpr int v_rd_off(int d0, int ks, int half) { return ((2 * ks + half) * VGeo<DV>::NCB + d0) * 512; }
template <int OFF> __device__ __forceinline__ s16x4 tr_read(int vb) { s16x4 r; asm volatile("ds_read_b64_tr_b16 %0, %1 offset:%2" : "=&v"(r) : "v"(vb), "i"(OFF) : "memory"); return r; }
template <int DV, int D0> __device__ __forceinline__ void pv_one(f32x16& od, int vb, bf16x8 pa0, bf16x8 pa1, bf16x8 pa2, bf16x8 pa3) {
    const s16x4 l0 = tr_read<v_rd_off<DV>(D0, 0, 0)>(vb), h0 = tr_read<v_rd_off<DV>(D0, 0, 1)>(vb), l1 = tr_read<v_rd_off<DV>(D0, 1, 0)>(vb), h1 = tr_read<v_rd_off<DV>(D0, 1, 1)>(vb);
    const s16x4 l2 = tr_read<v_rd_off<DV>(D0, 2, 0)>(vb), h2 = tr_read<v_rd_off<DV>(D0, 2, 1)>(vb), l3 = tr_read<v_rd_off<DV>(D0, 3, 0)>(vb), h3 = tr_read<v_rd_off<DV>(D0, 3, 1)>(vb);
    asm volatile("s_waitcnt lgkmcnt(0)" ::: "memory"); SBAR();
#define PK(L, H) (bf16x8){L[0], L[1], L[2], L[3], H[0], H[1], H[2], H[3]}
    od = MFMA32(pa0, PK(l0, h0), od);
    od = MFMA32(pa1, PK(l1, h1), od);
    od = MFMA32(pa2, PK(l2, h2), od);
    od = MFMA32(pa3, PK(l3, h3), od);
#undef PK
}
template <int DV> __device__ __forceinline__ void pv_all(f32x16* o, int vb, bf16x8 pa0, bf16x8 pa1, bf16x8 pa2, bf16x8 pa3) {
    pv_one<DV, 0>(o[0], vb, pa0, pa1, pa2, pa3); pv_one<DV, 1>(o[1], vb, pa0, pa1, pa2, pa3);
    if constexpr (DV == 128) { pv_one<DV, 2>(o[2], vb, pa0, pa1, pa2, pa3); pv_one<DV, 3>(o[3], vb, pa0, pa1, pa2, pa3); }
}
__device__ __forceinline__ void na_bias(f32x16& p0, f32x16& p1, int kr, int rq, int cq, int hi, const LAS float* rpb) {
    const int r0q = min(max(rq - 4, 0), 56);
    const bool vrow = (kr >= r0q) && (kr < r0q + 8);
    const LAS float* rowp = rpb + (vrow ? (kr - rq + 7) : 0) * 31;
    const int c0 = min(max(cq - 8, 0), 48);
    const float NEG = -INFINITY;
#pragma unroll
    for (int r = 0; r < 16; ++r) {
        const int ck0 = crow(r, hi), ck1 = ck0 + 32;
        const bool ok0 = vrow && (ck0 >= c0) && (ck0 < c0 + 16), ok1 = vrow && (ck1 >= c0) && (ck1 < c0 + 16);
        const int i0 = min(max(ck0 - cq, -15), 15) + 15, i1 = min(max(ck1 - cq, -15), 15) + 15;
        const float b0 = rowp[i0], b1 = rowp[i1];
        p0[r] = ok0 ? p0[r] + b0 : NEG; p1[r] = ok1 ? p1[r] + b1 : NEG;
    }
}

struct DiffArgs { float* Sc; float lam; const float* g; };
template <int DK, int DV, bool NA, int EPI>
__device__ __forceinline__ void attn_unit(const bf16_t* Qb, int ldq, const bf16_t* Kh, int ldk, const bf16_t* Vh, int ldv, bf16_t* Ob, int ldo,
                                          int t0, int NT, LAS char* lds, const NAArgs na, const DiffArgs da, const int tid_in) {
    int tid = tid_in; asm volatile("" : "+v"(tid));
    constexpr int KROWB = KGeo<DK>::ROWB, KBYTES = KGeo<DK>::BYTES, VBYTES = VGeo<DV>::BYTES, NO = DV / 32;
    const int wid = __builtin_amdgcn_readfirstlane(tid >> 6), lane = tid & 63, r32 = lane & 31, hi = lane >> 5;
    LAS char* V_lds = lds; LAS char* K_lds = lds + Geo<DK, DV>::KOFF;
    LAS float* ws = (LAS float*)(lds + Geo<DK, DV>::WSOFF) + wid * 64; LAS float* li_l = ws; LAS float* al_l = ws + 32;
    float m_reg = 0.f, l_reg = 0; f32x16 o[NO]; bf16x8 qr[DK / 16]; f32x16 negm = f32x16{}; bool first = true;
#pragma unroll
    for (int d = 0; d < NO; ++d) o[d] = f32x16{};
    const bf16_t* Qw = Qb + (size_t)(wid * QBLK + r32) * ldq + hi * 8;
#pragma unroll
    for (int d0 = 0; d0 < DK / 16; ++d0) qr[d0] = *(const bf16x8*)(Qw + d0 * 16);
    int krow0, kch0, krow1 = 0, kch1 = 0;
    if constexpr (DK == 64) { krow0 = tid >> 3; kch0 = tid & 7; }
    else { krow0 = tid / 12; kch0 = tid % 12; const int i1 = tid + 512; krow1 = i1 / 12; kch1 = i1 % 12; }
    const bool k2 = (DK == 96) && (tid < 256);
    int vrow0, vcol0;
    if constexpr (DV == 64) { vrow0 = tid >> 3; vcol0 = (tid & 7) * 8; } else { vrow0 = tid >> 4; vcol0 = (tid & 15) * 8; }
    const int vst0 = v_st<DV>(vrow0, vcol0), vst1 = v_st<DV>(32 + vrow0, vcol0);
    const int vb0 = (int)(uintptr_t)V_lds + v_rd_base(lane);
    bf16x8 ks0, ks1, vs0, vs1;
#define SLOAD(kk) do { const size_t k0_ = (size_t)(kk); ks0 = *(const bf16x8*)(Kh + (k0_ + krow0) * ldk + kch0 * 8); \
        if (k2) ks1 = *(const bf16x8*)(Kh + (k0_ + krow1) * ldk + kch1 * 8); \
        vs0 = *(const bf16x8*)(Vh + (k0_ + vrow0) * ldv + vcol0); \
        if constexpr (DV == 128) vs1 = *(const bf16x8*)(Vh + (k0_ + 32 + vrow0) * ldv + vcol0); } while (0)
#define SWRITE(b) do { *(LAS bf16x8*)(K_lds + (b) * KBYTES + krow0 * KROWB + kch0 * 16) = ks0; \
        if (k2) *(LAS bf16x8*)(K_lds + (b) * KBYTES + krow1 * KROWB + kch1 * 16) = ks1; \
        *(LAS bf16x8*)(V_lds + (b) * VBYTES + vst0) = vs0; \
        if constexpr (DV == 128) *(LAS bf16x8*)(V_lds + (b) * VBYTES + vst1) = vs1; } while (0)
#define RESC(a) do { if (__any((a) < 1.f)) { if (hi == 0) al_l[r32] = (a); asm volatile("s_waitcnt lgkmcnt(0)" ::: "memory"); \
        _Pragma("unroll") for (int d = 0; d < NO; ++d) _Pragma("unroll") for (int r = 0; r < 16; ++r) o[d][r] *= al_l[crow(r, hi)]; } } while (0)
    const int rq = NA ? (4 * na.qb + (wid >> 1)) : 0, cq = NA ? (32 * (wid & 1) + r32) : 0;
    const int r0q_ = NA ? min(max(rq - 4, 0), 56) : 0;
    bool vA = true, vB = true;
#define QKT(P0, P1, KB, t, VF) do { if constexpr (NA) { VF = ((t) >= r0q_) && ((t) < r0q_ + 8); \
        if (VF) { qkt<DK>(P0, P1, KB, qr, r32, hi, negm); na_bias(P0, P1, (t), rq, cq, hi, na.rpb); } \
        else { _Pragma("unroll") for (int r_ = 0; r_ < 16; ++r_) { P0[r_] = -INFINITY; P1[r_] = -INFINITY; } } } \
      else { qkt<DK>(P0, P1, KB, qr, r32, hi, negm); } } while (0)
#define PV(VOFF, VF) do { if (!NA || (VF)) pv_all<DV>(o, vb0 + (VOFF), pa0, pa1, pa2, pa3); } while (0)
#define PSM(P0, P1, MN, AL, VF) do { if (!NA || (VF)) partialSM(P0, P1, m_reg, negm, AL, first); else { AL = 1.f; } } while (0)
#define FSM(P0, P1, AL, VF) do { if (!NA || (VF)) finishSM(P0, P1, AL, l_reg, pa0, pa1, pa2, pa3); } while (0)
    f32x16 pA0, pA1, pB0, pB1; float mnA, mnB, alA, alB; bf16x8 pa0, pa1, pa2, pa3;
    const int kbase = t0 * KVBLK;
    SLOAD(kbase); SWRITE(0); __syncthreads();
    QKT(pA0, pA1, K_lds, t0, vA); PSM(pA0, pA1, mnA, alA, vA);
    SLOAD(kbase + KVBLK); SWRITE(1); __syncthreads();
    for (int j = 1; j + 1 < NT; j += 2) {
        SBAR(); QKT(pB0, pB1, K_lds + KBYTES, t0 + j, vB);
        FSM(pA0, pA1, alA, vA); SBAR();
        SLOAD(kbase + (j + 1) * KVBLK); SBAR();
        PV(0, vA); PSM(pB0, pB1, mnB, alB, vB);
        __syncthreads(); SWRITE(0);
        RESC(alB); __syncthreads();
        SBAR(); QKT(pA0, pA1, K_lds, t0 + j + 1, vA);
        FSM(pB0, pB1, alB, vB); SBAR();
        SLOAD(kbase + (j + 2) * KVBLK); SBAR();
        PV(VBYTES, vB); PSM(pA0, pA1, mnA, alA, vA);
        __syncthreads(); SWRITE(1);
        RESC(alA); __syncthreads();
    }
    SBAR(); QKT(pB0, pB1, K_lds + KBYTES, t0 + NT - 1, vB);
    FSM(pA0, pA1, alA, vA); SBAR();
    PV(0, vA); PSM(pB0, pB1, mnB, alB, vB);
    __syncthreads(); RESC(alB);
    FSM(pB0, pB1, alB, vB); SBAR();
    PV(VBYTES, vB);
    if (hi == 0) li_l[r32] = l_reg; asm volatile("s_waitcnt lgkmcnt(0)" ::: "memory");
    int l2 = lane; asm volatile("" : "+v"(l2));
    const int r32e = l2 & 31, hie = l2 >> 5;
    float rli[16];
#pragma unroll
    for (int r = 0; r < 16; ++r) rli[r] = __builtin_amdgcn_rcpf(li_l[crow(r, hie)]);
    bf16_t* Ow = Ob + (size_t)(wid * QBLK + 4 * hie) * ldo + r32e;
    if constexpr (EPI == 0) {
#pragma unroll
        for (int r = 0; r < 16; ++r) { const int orow = (r & 3) + 8 * (r >> 2);
#pragma unroll
            for (int d0 = 0; d0 < NO; ++d0) Ow[orow * ldo + d0 * 32] = (bf16_t)f2bf(o[d0][r] * rli[r]); }
    } else {
        float* Sw = da.Sc + (size_t)(wid * QBLK + 4 * hie) * 512 + r32e;
        if constexpr (EPI == 1) {
#pragma unroll
            for (int r = 0; r < 16; ++r) { const int orow = (r & 3) + 8 * (r >> 2);
#pragma unroll
                for (int d0 = 0; d0 < NO; ++d0) Sw[orow * 512 + d0 * 32] = o[d0][r] * rli[r]; }
        } else {
            float gg[NO];
#pragma unroll
            for (int d0 = 0; d0 < NO; ++d0) gg[d0] = da.g[d0 * 32 + r32e] * 0.8f;
#pragma unroll
            for (int r = 0; r < 16; ++r) { const int orow = (r & 3) + 8 * (r >> 2);
                float v[NO]; float sq = 0.f;
#pragma unroll
                for (int d0 = 0; d0 < NO; ++d0) { v[d0] = Sw[orow * 512 + d0 * 32] - da.lam * (o[d0][r] * rli[r]); sq += v[d0] * v[d0]; }
                sq += __shfl_xor(sq, 1); sq += __shfl_xor(sq, 2); sq += __shfl_xor(sq, 4); sq += __shfl_xor(sq, 8); sq += __shfl_xor(sq, 16);
                const float rs = rsqrtf(sq * (1.0f / 128.0f) + RMS_EPS);
#pragma unroll
                for (int d0 = 0; d0 < NO; ++d0) Ow[orow * ldo + d0 * 32] = (bf16_t)f2bf(v[d0] * rs * gg[d0]); }
        }
    }
    __syncthreads();
#undef SLOAD
#undef SWRITE
#undef RESC
#undef QKT
#undef PV
#undef PSM
#undef FSM
}
#undef SBAR
}

typedef GAS unsigned gu32;
#define RLX_AGENT __ATOMIC_RELAXED, __HIP_MEMORY_SCOPE_AGENT
#define XB_TMO      128
#define XB_XCNT(j)  (256  + 64 * (j))
#define XB_XSUB(j)  (1280 + 64 * (j))
#define XB_XGEN(j)  (2304 + 64 * (j))
#define XB_TOP      3328
#define XB_TOPGEN   3392
#define XCD_BAR_WORDS 3456
#define XB_SPIN_CAP (1u << 18)
__device__ __forceinline__ unsigned xb_ld(unsigned* p)              { return __hip_atomic_load(p, __ATOMIC_RELAXED, __HIP_MEMORY_SCOPE_AGENT); }
__device__ __forceinline__ unsigned xb_add(unsigned* p, unsigned v) { return __hip_atomic_fetch_add(p, v, __ATOMIC_RELAXED, __HIP_MEMORY_SCOPE_AGENT); }
__device__ __forceinline__ unsigned xb_xcc_id() { return (unsigned)__builtin_amdgcn_s_getreg((3 << 11) | 20) & 0xFu; }
#define XB_SPIN(cond, bar) do { unsigned _sp = 0; while (cond) { __builtin_amdgcn_s_sleep(1); \
    if ((++_sp & 255u) == 0u) { if (xb_ld(&(bar)[XB_TMO])) break; if (_sp > XB_SPIN_CAP) { atomicAdd(&(bar)[XB_TMO], 1u); break; } } } } while (0)
struct XcdBarrier { unsigned* bar; unsigned x; volatile LAS unsigned* st; };
__device__ __forceinline__ XcdBarrier xcd_barrier_post(unsigned* bar, volatile LAS unsigned* st, bool leader) {
    XcdBarrier b; b.bar = bar; b.x = xb_xcc_id(); b.st = st;
    if (leader) (void)xb_add(&bar[XB_XCNT(b.x)], 1u);
    return b;
}
__device__ __forceinline__ void xcd_barrier_complete(unsigned* bar, unsigned x, unsigned& nloc, unsigned& nx) {
    const unsigned G = gridDim.x * gridDim.y * gridDim.z;
    unsigned sum, cnt, mine, sp = 0u;
    for (;;) {
        sum = 0u; cnt = 0u; mine = 0u;
#pragma unroll
        for (unsigned j = 0; j < 16; ++j) { const unsigned c = xb_ld(&bar[XB_XCNT(j)]); sum += c; cnt += (c > 0u) ? 1u : 0u; mine = (j == x) ? c : mine; }
        if (sum == G) break;
        __builtin_amdgcn_s_sleep(1);
        if ((++sp & 255u) == 0u) { if (xb_ld(&bar[XB_TMO])) break; if (sp > XB_SPIN_CAP) { atomicAdd(&bar[XB_TMO], 1u); break; } }
    }
    nloc = mine > 0u ? mine : 1u; nx = cnt > 0u ? cnt : 1u;
}
__device__ __forceinline__ void xcd_barrier(const XcdBarrier& b, bool leader) {
    asm volatile("s_waitcnt vmcnt(0)" ::: "memory");
    __syncthreads();
    if (leader) {
        unsigned* bar = b.bar;
        __builtin_amdgcn_s_waitcnt(0);
        unsigned nloc = b.st[0], nx = b.st[1];
        if (nloc == 0u) { xcd_barrier_complete(bar, b.x, nloc, nx); b.st[0] = nloc; b.st[1] = nx; }
        const unsigned old = xb_add(&bar[XB_XSUB(b.x)], 1u);
        const unsigned gen = old / nloc;
        if (old + 1u == (gen + 1u) * nloc) {
            __builtin_amdgcn_fence(__ATOMIC_RELEASE, "agent");
            asm volatile("s_waitcnt vmcnt(0)" ::: "memory");
            const unsigned og = xb_add(&bar[XB_TOP], 1u);
            const unsigned tg = og / nx;
            if (og + 1u == (tg + 1u) * nx) xb_add(&bar[XB_TOPGEN], 1u);
            else XB_SPIN(xb_ld(&bar[XB_TOPGEN]) == tg, bar);
            __builtin_amdgcn_fence(__ATOMIC_ACQUIRE, "agent");
            xb_add(&bar[XB_XGEN(b.x)], 1u);
            asm volatile("s_waitcnt vmcnt(0)" ::: "memory");
        } else {
            XB_SPIN(xb_ld(&bar[XB_XGEN(b.x)]) == gen, bar);
            __builtin_amdgcn_fence(__ATOMIC_ACQUIRE, "agent");
            asm volatile("s_waitcnt vmcnt(0)" ::: "memory");
        }
    }
    __syncthreads();
}

struct Args { const float* in[29]; float* out; unsigned char* ws; int ph_lo, ph_hi; };
typedef const __attribute__((address_space(4))) Args* ArgsP;
#define AIN(a, i) ((const float*)(const GAS float*)((a)->in[i]))
#define AOUT(a) ((float*)(GAS float*)((a)->out))
#define AWS(a) ((unsigned char*)(GAS unsigned char*)((a)->ws))
enum { I_X = 0, I_F1N, I_F1G, I_F1U, I_F1D, I_MIXN, I_F2N, I_F2G, I_F2U, I_F2D, I_FINN, I_EVIN, I_EVOUT, I_DLAM, I_DSUB, I_RPB, I_ODIN, I_ODOUT,
       I_CONVW, I_CONVB, I_RGWA, I_RGBA, I_RGWX, I_RGBX, I_RGLAM, I_GQ, I_GKV, I_WUQ, I_WUKV };


template <class ColPtr>
__device__ __forceinline__ void conv_item(int ldw, int K, bf16_t* WT, const float* gain, LAS bf16_t* T, int kb, int nb, int lane, ColPtr colptr) {
    const int k0 = 64 * kb, n0 = 64 * nb, cg = (lane & 15) * 4, rl = lane >> 4;
    const float* src = colptr(n0 + cg);
    f32x4 v[16];
#pragma unroll
    for (int i = 0; i < 16; ++i) v[i] = src ? *(const f32x4*)(src + (size_t)(k0 + 4 * i + rl) * ldw) : (f32x4){0.f, 0.f, 0.f, 0.f};
#pragma unroll
    for (int i = 0; i < 16; ++i) { const int kk = 4 * i + rl; const float g = gain ? gain[k0 + kk] : 1.0f;
        const unsigned p0 = cvt_pk_bf16(v[i][0] * g, v[i][1] * g), p1 = cvt_pk_bf16(v[i][2] * g, v[i][3] * g);
        T[(cg + 0) * 72 + kk] = (bf16_t)(p0 & 0xffffu); T[(cg + 1) * 72 + kk] = (bf16_t)(p0 >> 16);
        T[(cg + 2) * 72 + kk] = (bf16_t)(p1 & 0xffffu); T[(cg + 3) * 72 + kk] = (bf16_t)(p1 >> 16); }
    asm volatile("s_waitcnt lgkmcnt(0)" ::: "memory");
    const int c = lane & 7;
#pragma unroll
    for (int j = 0; j < 8; ++j) { const int n = (lane >> 3) + 8 * j;
        const u32x4 w = *(const LAS u32x4*)(T + n * 72 + 8 * c);
        *(u32x4*)(WT + (size_t)(n0 + n) * K + k0 + 8 * c) = w; }
    asm volatile("s_waitcnt lgkmcnt(0)" ::: "memory");
}
__device__ __forceinline__ void sincos_acc(float ang, float& s, float& c) {
    const double TWO_PI = 6.283185307179586476925286766559, INV = 0.15915494309189533576888376337251;
    const double a = (double)ang, k = __builtin_rint(a * INV); const float r = (float)(a - k * TWO_PI);
    s = sinf(r); c = cosf(r);
}
constexpr int I_GU = (DM / 64) * (2 * FF / 64), I_D = (FF / 64) * (DM / 64), I_EI = (DM / 64) * (EVEN_IN / 64), I_O = (DM / 64) * (DM / 64), I_OI = (DM / 64) * (ODD_INP / 64),
              I_Q = (256 / 64) * (768 / 64), I_KV = (256 / 64) * (1024 / 64);
constexpr int CI_P0 = I_GU, CI_A = CI_P0 + I_D + I_EI + I_O + I_GU + I_D, CI_B = CI_A + I_GU + I_D + I_OI + I_O + I_Q + I_KV, CI_C = CI_B + I_GU + I_D;
__device__ __forceinline__ void conv_gu(ArgsP A, unsigned char* ws, LAS bf16_t* scr, int w, int r, int lane) {
    const int l = w >> 1, f = w & 1, nblk = 2 * FF / 64, kb = r / nblk, nb = r % nblk;
    const float* wg = AIN(A, f ? I_F2G : I_F1G) + (size_t)l * DM * FF; const float* wu = AIN(A, f ? I_F2U : I_F1U) + (size_t)l * DM * FF;
    const float* gain = AIN(A, f ? I_F2N : I_F1N) + l * DM;
    conv_item(FF, DM, (bf16_t*)(ws + WS_WGU + (size_t)w * SZ_WGU), gain, scr, kb, nb, lane,
              [&](int n) -> const float* { const int t = n >> 8, q = n & 255; return (q < 128) ? (wg + 128 * t + q) : (wu + 128 * t + (q - 128)); });
}
__device__ __forceinline__ void conv_d(ArgsP A, unsigned char* ws, LAS bf16_t* scr, int w, int r, int lane) {
    const int l = w >> 1, f = w & 1, nblk = DM / 64, kb = r / nblk, nb = r % nblk;
    const float* wd = AIN(A, f ? I_F2D : I_F1D) + (size_t)l * FF * DM;
    conv_item(DM, FF, (bf16_t*)(ws + WS_WD + (size_t)w * SZ_WD), nullptr, scr, kb, nb, lane, [&](int n) -> const float* { return wd + n; });
}
__device__ __forceinline__ void conv_items(ArgsP A, LAS unsigned char* lds, int lo, int hi, int wi, int NW_, int wave, int lane) {
    unsigned char* ws = AWS(A);
    LAS bf16_t* scr = (LAS bf16_t*)(lds + wave * 9216);
    for (int it = lo + wi; it < hi; it += NW_) {
        int r = it;
        if (r < I_GU) { conv_gu(A, ws, scr, 0, r, lane); continue; } r -= I_GU;
        if (r < I_D) { conv_d(A, ws, scr, 0, r, lane); continue; } r -= I_D;
        if (r < I_EI) { const int nblk = EVEN_IN / 64, kb = r / nblk, nb = r % nblk; const float* w = AIN(A, I_EVIN); const float* gain = AIN(A, I_MIXN);
            conv_item(EVEN_IN, DM, (bf16_t*)(ws + WS_EVIN), gain, scr, kb, nb, lane,
                      [&](int n) -> const float* { if (n >= 1024) return w + n; const int c = n & 255, bj = c >> 7, wc = (c >> 5) & 3, ww = c & 31; return w + (n & ~255) + 64 * wc + 32 * bj + ww; });
            continue; }
        r -= I_EI;
        if (r < I_O) { const int nblk = DM / 64, kb = r / nblk, nb = r % nblk; const float* w = AIN(A, I_EVOUT);
            conv_item(DM, DM, (bf16_t*)(ws + WS_EVOUT), nullptr, scr, kb, nb, lane, [&](int n) -> const float* { return w + n; });
            continue; }
        r -= I_O;
        if (r < I_GU) { conv_gu(A, ws, scr, 1, r, lane); continue; } r -= I_GU;
        if (r < I_D) { conv_d(A, ws, scr, 1, r, lane); continue; } r -= I_D;
        if (r < I_GU) { conv_gu(A, ws, scr, 2, r, lane); continue; } r -= I_GU;
        if (r < I_D) { conv_d(A, ws, scr, 2, r, lane); continue; } r -= I_D;
        if (r < I_OI) { const int nblk = ODD_INP / 64, kb = r / nblk, nb = r % nblk; const float* w = AIN(A, I_ODIN); const float* gain = AIN(A, I_MIXN) + DM;
            conv_item(ODD_IN, DM, (bf16_t*)(ws + WS_ODIN), gain, scr, kb, nb, lane, [&](int n) -> const float* { return (n < ODD_IN) ? (w + n) : nullptr; });
            continue; }
        r -= I_OI;
        if (r < I_O) { const int nblk = DM / 64, kb = r / nblk, nb = r % nblk; const float* w = AIN(A, I_ODOUT);
            conv_item(DM, DM, (bf16_t*)(ws + WS_ODOUT), nullptr, scr, kb, nb, lane, [&](int n) -> const float* { return w + n; });
            continue; }
        r -= I_O;
        if (r < I_Q) { const int nblk = 768 / 64, kb = r / nblk, nb = r % nblk; const float* w = AIN(A, I_WUQ); const float* gain = AIN(A, I_GQ);
            conv_item(768, 256, (bf16_t*)(ws + WS_WUQ), gain, scr, kb, nb, lane,
                      [&](int n) -> const float* { if (n < 512) return w + (n >> 6) * 96 + (n & 63); const int c = n - 512, bj = c >> 7, wc = (c >> 5) & 3, ww = c & 31; return w + (2 * wc + (ww >> 4)) * 96 + 64 + 16 * bj + (ww & 15); });
            continue; }
        r -= I_Q;
        if (r < I_KV) { const int nblk = 1024 / 64, kb = r / nblk, nb = r % nblk; const float* w = AIN(A, I_WUKV); const bool real = kb < 2;
            conv_item(1024, 256, (bf16_t*)(ws + WS_WUKV), real ? AIN(A, I_GKV) : nullptr, scr, kb, nb, lane, [&](int n) -> const float* { return real ? (w + n) : nullptr; });
            continue; }
        r -= I_KV;
        if (r < I_GU) { conv_gu(A, ws, scr, 3, r, lane); continue; } r -= I_GU;
        conv_d(A, ws, scr, 3, r, lane);
    }
}
__device__ __forceinline__ void phase_p0(ArgsP A, LAS unsigned char* lds, int vcu, int G, int wave, int lane, int tid) {
    unsigned char* ws = AWS(A);
    const int gw = vcu * NWAVES + wave, NGW = G * NWAVES;
    conv_items(A, lds, 0, CI_P0, gw, NGW, wave, lane);
    { const int gt = vcu * (NWAVES * 64) + tid, NT_ = G * NWAVES * 64;
      float* cosA = (float*)(ws + WS_COSA); float* sinA = (float*)(ws + WS_SINA); float* cosD = (float*)(ws + WS_COSD); float* sinD = (float*)(ws + WS_SIND);
      for (int e = gt; e < SEQ * 32 + SEQ * 16; e += NT_) {
          int pos, i, dim; float* cp; float* sp;
          if (e < SEQ * 32) { pos = e >> 5; i = e & 31; dim = 64; cp = cosA + e; sp = sinA + e; } else { const int e2 = e - SEQ * 32; pos = e2 >> 4; i = e2 & 15; dim = 32; cp = cosD + e2; sp = sinD + e2; }
          const float inv = (float)(1.0 / exp2((double)(2 * i) / (double)dim * 13.287712379549449391481277717958));
          const float ang = (float)pos * inv; float s, c; sincos_acc(ang, s, c); *cp = c; *sp = s; }
      { float* spt = (float*)(ws + WS_SPT); for (int e = gt; e < 1024; e += NT_) spt[e] = log1pf(__expf(-AIN(A, I_RGLAM)[e])); }
      bf16_t* rgw = (bf16_t*)(ws + WS_RGW);
      for (int e = gt; e < 4 * 8 * 64 * 64; e += NT_) { const int k = e & 63, o = (e >> 6) & 63, n = (e >> 12) & 7, gd = e >> 15, dir = gd >> 1, gate = gd & 1;
          const float* src = AIN(A, gate ? I_RGWX : I_RGWA) + ((size_t)(dir * 8 + n) * 64 + k) * 64 + o; rgw[e] = (bf16_t)f2bf(*src); }
    }
    { const float* x = AIN(A, I_X); bf16_t* xb = (bf16_t*)(ws + WS_XB); float* ssq = (float*)(ws + WS_SSQ16);
      for (int m = gw; m < M; m += NGW) {
          const f32x4* xr = (const f32x4*)(x + (size_t)m * DM) + lane; f32x4 v[4]; float s = 0.f;
#pragma unroll
          for (int j = 0; j < 4; ++j) { v[j] = xr[64 * j]; s += (v[j].x * v[j].x + v[j].y * v[j].y) + (v[j].z * v[j].z + v[j].w * v[j].w); }
          s = wave_sum(s);
          u32x2* o8 = (u32x2*)(xb + (size_t)m * DM) + lane;
#pragma unroll
          for (int j = 0; j < 4; ++j) { u32x2 w; w.x = cvt_pk_bf16(v[j].x, v[j].y); w.y = cvt_pk_bf16(v[j].z, v[j].w); o8[64 * j] = w; }
          if (lane < 16) ssq[(size_t)m * 16 + lane] = (lane == 0) ? s : 0.f;
      } }
}

__device__ __forceinline__ void phase_final(ArgsP A, int vcu, int G, int wave, int lane) {
    float* out = AOUT(A); const float* g = AIN(A, I_FINN); const bf16_t* xb = (const bf16_t*)(AWS(A) + WS_XB); const float* ssq = (const float*)(AWS(A) + WS_SSQ16);
    f32x4 gv[4];
#pragma unroll
    for (int j = 0; j < 4; ++j) gv[j] = ((const f32x4*)g)[lane + 64 * j];
    const int gw = vcu * NWAVES + wave, NGW = G * NWAVES;
    for (int m = gw; m < M; m += NGW) {
        const u32x2* xr = (const u32x2*)(xb + (size_t)m * DM) + lane; u32x2 v[4];
#pragma unroll
        for (int j = 0; j < 4; ++j) v[j] = xr[64 * j];
        const float rs = rsqrtf(sum16(ssq + (size_t)m * 16) * (1.0f / DM) + RMS_EPS);
        f32x4* orow = (f32x4*)(out + (size_t)m * DM) + lane;
#pragma unroll
        for (int j = 0; j < 4; ++j) { const f32x4 x = {bf2f((bf16_t)(v[j].x & 0xffffu)), bf2f((bf16_t)(v[j].x >> 16)), bf2f((bf16_t)(v[j].y & 0xffffu)), bf2f((bf16_t)(v[j].y >> 16))};
            orow[64 * j] = x * rs * gv[j]; }
    }
}

__device__ __forceinline__ void phase_kpe(ArgsP A, int vcu, int G, int wave, int lane) {
    const bf16_t* OD = (const bf16_t*)(AWS(A) + WS_OD); bf16_t* Kf = (bf16_t*)(AWS(A) + WS_KF);
    const float* cosD = (const float*)(AWS(A) + WS_COSD); const float* sinD = (const float*)(AWS(A) + WS_SIND);
    const int gw = vcu * NWAVES + wave, NGW = G * NWAVES; const int d = 2 * (lane & 7), rr = lane >> 3;
    for (int m0 = 8 * gw; m0 < M; m0 += 8 * NGW) {
        const int m = m0 + rr, pos = m & (SEQ - 1);
        const unsigned xa = *(const unsigned*)(OD + (size_t)m * ODD_INP + 1408 + d), xb2 = *(const unsigned*)(OD + (size_t)m * ODD_INP + 1424 + d);
        const f32x2 c = *(const f32x2*)(cosD + pos * 16 + d), sn = *(const f32x2*)(sinD + pos * 16 + d);
        const float x1a = bf2f((bf16_t)(xa & 0xffffu)), x1b = bf2f((bf16_t)(xa >> 16)), x2a = bf2f((bf16_t)(xb2 & 0xffffu)), x2b = bf2f((bf16_t)(xb2 >> 16));
        const unsigned o1 = cvt_pk_bf16(x1a * c.x - x2a * sn.x, x1b * c.y - x2b * sn.y), o2 = cvt_pk_bf16(x1a * sn.x + x2a * c.x, x1b * sn.y + x2b * c.y);
        bf16_t* kp = Kf + (size_t)m * 768 + 64 + d;
#pragma unroll
        for (int h = 0; h < 8; ++h) { *(unsigned*)(kp + h * 96) = o1; *(unsigned*)(kp + h * 96 + 16) = o2; }
    }
}

constexpr int RG2_U = 0, RG2_G = 66560, RG2_GC = RG2_G + 33280, RG2_END = RG2_GC + 16640;
static_assert(RG2_END <= RING_BYTES, "rg lds");
template <int PASS>
__device__ __forceinline__ void rg_chunk(ArgsP A, LAS unsigned char* lds, int b, int j, int wave, int tid_in) {
    int tid = tid_in; asm volatile("" : "+v"(tid)); const int lane = tid & 63;
    const bf16_t* OD = (const bf16_t*)(AWS(A) + WS_OD); bf16_t* mix = (bf16_t*)(AWS(A) + WS_MIX); float* SUM = (float*)(AWS(A) + WS_SUM);
    const bf16_t* rgw = (const bf16_t*)(AWS(A) + WS_RGW); const float* spt = (const float*)(AWS(A) + WS_SPT);
    LAS bf16_t* U = (LAS bf16_t*)(lds + RG2_U); LAS bf16_t* G = (LAS bf16_t*)(lds + RG2_G); LAS bf16_t* GC = (LAS bf16_t*)(lds + RG2_GC);
    const size_t row0 = (size_t)b * SEQ + 64 * j;
    float cinf = 0.f, cinb = 0.f;
    if (PASS == 2) {
        const f32x2* Sf = (const f32x2*)SUM + ((size_t)b * 64 * 2 + 0) * 512 + tid;
        const f32x2* Sb = (const f32x2*)SUM + ((size_t)b * 64 * 2 + 1) * 512 + tid;
        float C = 0.f;
#pragma unroll 1
        for (int kb = 0; kb < 64; kb += 32) { if (kb >= j) break; f32x2 sv[32];
#pragma unroll
            for (int u = 0; u < 32; ++u) sv[u] = Sf[(size_t)(kb + u) * 1024];
#pragma unroll
            for (int u = 0; u < 32; ++u) C = (kb + u < j) ? sv[u].x * C + sv[u].y : C; }
        cinf = C; C = 0.f;
#pragma unroll 1
        for (int kb = 63; kb >= 0; kb -= 32) { if (kb <= j) break; f32x2 sv[32];
#pragma unroll
            for (int u = 0; u < 32; ++u) sv[u] = Sb[(size_t)(kb - u) * 1024];
#pragma unroll
            for (int u = 0; u < 32; ++u) C = (kb - u > j) ? sv[u].x * C + sv[u].y : C; }
        cinb = C;
    }
    {
        const int cp = tid & 255, th = tid >> 8, c0 = 2 * cp;
        const float* cw = AIN(A, I_CONVW);
        const f32x2 w0 = *(const f32x2*)(cw + c0), w1 = *(const f32x2*)(cw + 512 + c0), w2 = *(const f32x2*)(cw + 1024 + c0), w3 = *(const f32x2*)(cw + 1536 + c0), cb = *(const f32x2*)(AIN(A, I_CONVB) + c0);
        unsigned xr[35];
#pragma unroll
        for (int k = 0; k < 35; ++k) { const int tok = 64 * j + 32 * th - 1 + k; xr[k] = (tok >= 0 && tok < SEQ) ? *(const unsigned*)(OD + ((size_t)b * SEQ + tok) * ODD_INP + c0) : 0u; }
#pragma unroll
        for (int i = 0; i < 32; ++i) {
            const float ulo = w0.x * bf2f((bf16_t)(xr[i] & 0xffffu)) + w1.x * bf2f((bf16_t)(xr[i + 1] & 0xffffu)) + w2.x * bf2f((bf16_t)(xr[i + 2] & 0xffffu)) + w3.x * bf2f((bf16_t)(xr[i + 3] & 0xffffu)) + cb.x;
            const float uhi = w0.y * bf2f((bf16_t)(xr[i] >> 16)) + w1.y * bf2f((bf16_t)(xr[i + 1] >> 16)) + w2.y * bf2f((bf16_t)(xr[i + 2] >> 16)) + w3.y * bf2f((bf16_t)(xr[i + 3] >> 16)) + cb.y;
            *(LAS unsigned*)(U + (32 * th + i) * 520 + c0) = cvt_pk_bf16(ulo, uhi); }
    }
    __syncthreads();
    const int n = wave, fr = lane & 15, kg = lane >> 4;
    float hf[64];
#pragma unroll
    for (int d = 0; d < 2; ++d) {
        bf16x8 bw[2][4][2]; float bs[2][4];
#pragma unroll
        for (int gate = 0; gate < 2; ++gate)
#pragma unroll
            for (int ot = 0; ot < 4; ++ot) { bs[gate][ot] = AIN(A, gate ? I_RGBX : I_RGBA)[d * 512 + n * 64 + 16 * ot + fr];
#pragma unroll
                for (int ks = 0; ks < 2; ++ks) bw[gate][ot][ks] = *(const bf16x8*)(rgw + (((size_t)(2 * d + gate) * 8 + n) * 64 + 16 * ot + fr) * 64 + 32 * ks + 8 * kg); }
        const float kk = -8.0f * LOG2E * spt[d * 512 + tid];
        float h = (PASS == 2) ? (d == 0 ? cinf : cinb) : 0.f, Atot = 1.f;
#pragma unroll
        for (int qq = 0; qq < 4; ++qq) { const int q = (d == 0) ? qq : 3 - qq;
            u32x4 gcr[2];
            if (PASS == 2 && d == 1) {
#pragma unroll
                for (int i = 0; i < 2; ++i) { const int c = tid + 512 * i; gcr[i] = *(const u32x4*)(OD + (row0 + 16 * q + (c >> 6)) * ODD_INP + 512 + 8 * (c & 63)); } }
            bf16x8 af[2];
#pragma unroll
            for (int ks = 0; ks < 2; ++ks) af[ks] = *(const LAS bf16x8*)(U + (16 * q + fr) * 520 + n * 64 + 32 * ks + 8 * kg);
#pragma unroll
            for (int gate = 0; gate < 2; ++gate)
#pragma unroll
                for (int ot = 0; ot < 4; ++ot) {
                    f32x4 dd = (f32x4){0.f, 0.f, 0.f, 0.f};
                    dd = MFMA16(af[0], bw[gate][ot][0], dd);
                    dd = MFMA16(af[1], bw[gate][ot][1], dd);
#pragma unroll
                    for (int e = 0; e < 4; ++e) G[(gate * 16 + 4 * kg + e) * 520 + n * 64 + 16 * ot + fr] = (bf16_t)f2bf(fast_sigmoid(dd[e] + bs[gate][ot]));
                }
            if (PASS == 2 && d == 1) {
#pragma unroll
                for (int i = 0; i < 2; ++i) { const int c = tid + 512 * i; *(LAS u32x4*)(GC + (c >> 6) * 520 + 8 * (c & 63)) = gcr[i]; } }
            __syncthreads();
#pragma unroll
            for (int i = 0; i < 16; ++i) { const int tl = (d == 0) ? i : 15 - i, tok = 16 * q + tl;
                const float u = bf2f(U[tok * 520 + tid]), r = bf2f(G[tl * 520 + tid]), ig = bf2f(G[(16 + tl) * 520 + tid]);
                const float a = __builtin_amdgcn_exp2f(kk * r);
                float mult = __builtin_amdgcn_sqrtf(fmaxf(1.0f - a * a, 0.f));
                if (d == 0 && tok == 0) mult = (j == 0) ? 1.0f : mult;
                if (d == 1 && tok == 63) mult = (j == 63) ? 1.0f : mult;
                h = a * h + mult * ig * u;
                if (PASS == 1) Atot *= a;
                if (PASS == 2) {
                    if (d == 0) hf[tok] = h;
                    else { const float gc = bf2f(GC[tl * 520 + tid]);
                        const float y = 0.7978845608028654f * (gc + 0.044715f * gc * gc * gc); const float th2 = 1.0f - 2.0f * __builtin_amdgcn_rcpf(__builtin_amdgcn_exp2f(2.0f * LOG2E * y) + 1.0f);
                        U[tok * 520 + tid] = (bf16_t)f2bf(0.5f * gc * (1.0f + th2) * (hf[tok] + h)); } } }
            __syncthreads();
        }
        if (PASS == 1) *(f32x2*)(SUM + ((((size_t)b * 64 + j) * 2 + d) * 512 + tid) * 2) = (f32x2){Atot, h};
    }
    if (PASS == 2) {
#pragma unroll
        for (int i = 0; i < 8; ++i) { const int c = tid + 512 * i, row = c >> 6, ch8 = (c & 63) * 8;
            const u32x4 v = *(const LAS u32x4*)(U + row * 520 + ch8);
            *(u32x4*)(mix + (row0 + row) * 1024 + ch8) = v; }
    }
    __syncthreads();
}

constexpr int NSTEP = 23;
#ifndef PH_MASK
#define PH_MASK 0x7fffff
#endif
#define S_ON(k) (((PH_MASK) >> (k)) & 1)
#ifndef DUP_MASK
#define DUP_MASK 0x0
#endif
#define STEP_BEGIN(k) if (S_ON(k) && ph_lo <= (k) && (k) < ph_hi) { const int nrep_ = 1 + (((DUP_MASK) >> (k)) & 1); for (int rep_ = 0; rep_ < nrep_; ++rep_) { \
        int tid = wave_s * 64 + (int)__builtin_amdgcn_mbcnt_hi(~0u, __builtin_amdgcn_mbcnt_lo(~0u, 0u)); asm volatile("" : "+v"(tid)); \
        int bx = blockIdx.x; asm volatile("" : "+s"(bx)); \
        ArgsP args = (ArgsP)__builtin_amdgcn_kernarg_segment_ptr(); asm volatile("" : "+s"(args)); \
        const int lane = tid & 63, wave = __builtin_amdgcn_readfirstlane(tid >> 6); \
        const int G = gridDim.x, vcu = (G % 8 == 0) ? (bx % 8) * (G / 8) + bx / 8 : bx; \
        unsigned char* ws = AWS(args); (void)lane; (void)wave; (void)vcu; (void)ws;
#define STEP_END(k, BAR) if ((k) + 1 < ph_hi || rep_ + 1 < nrep_) { if (BAR) xcd_barrier(bar, tid == 0); else __syncthreads(); } } }

#define DO_UP(par) do { pg8::Gemm g{(const bf16_t*)(ws + WS_XB), (const bf16_t*)(ws + WS_WGU + (size_t)(par) * SZ_WGU), DM, 2 * FF, DM}; pg8::StaticOrder S; S.init(M, 2 * FF, G, bx); \
        pg8::EpiSwiglu E{(bf16_t*)(ws + WS_H), (const float*)(ws + WS_SSQ16)}; pg8::gemm_phase(lds, g, S, E, pg8::RsSpec{(const float*)(ws + WS_SSQ16), 16, 1.0f / DM}, tid); } while (0)
#define DO_TAIL(lo_, hi_) do { const int nU_ = (M / 256) * (2 * FF / 256), nfull_ = nU_ % G; \
        if (nfull_ != 0 && bx >= nfull_) conv_items(args, lds, (lo_), (hi_), (bx - nfull_) * NWAVES + wave, (G - nfull_) * NWAVES, wave, lane); \
        else if (nfull_ == 0) conv_items(args, lds, (lo_), (hi_), bx * NWAVES + wave, G * NWAVES, wave, lane); } while (0)
#define DO_DOWN(par) do { pg8::Gemm g{(const bf16_t*)(ws + WS_H), (const bf16_t*)(ws + WS_WD + (size_t)(par) * SZ_WD), FF, DM, FF}; pg8::StaticOrder S; S.init(M, DM, G, bx); \
        pg8::EpiResid E{(bf16_t*)(ws + WS_XB), (float*)(ws + WS_SSQ16), (rep_ + 1 < nrep_) ? 0.0f : 0.5f}; pg8::gemm_phase(lds, g, S, E, pg8::RsSpec{nullptr, 0, 0.f}, tid); } while (0)
#define DO_OUT(par) do { pg8::Gemm g{(const bf16_t*)(ws + WS_MIX), (const bf16_t*)(ws + ((par) == 0 ? WS_EVOUT : WS_ODOUT)), DM, DM, DM}; pg8::StaticOrder S; S.init(M, DM, G, bx); \
        pg8::EpiResid E{(bf16_t*)(ws + WS_XB), (float*)(ws + WS_SSQ16), (rep_ + 1 < nrep_) ? 0.0f : 1.0f}; pg8::gemm_phase(lds, g, S, E, pg8::RsSpec{nullptr, 0, 0.f}, tid); } while (0)

__global__ void __launch_bounds__(NWAVES * 64, 2) mk_fwd(Args args_k) {
    extern __shared__ __attribute__((aligned(16))) unsigned char lds_raw[];
    LAS unsigned char* lds = (LAS unsigned char*)lds_raw;
    volatile LAS unsigned* MISC = (volatile LAS unsigned*)(lds + MISC_OFF);
    const int t0_ = threadIdx.x;
    const int wave_s = __builtin_amdgcn_readfirstlane(t0_ >> 6);
    for (int u = t0_; u < (LDS_BYTES - LDSCTL_OFF) / 4; u += NWAVES * 64) ((LAS unsigned*)(lds + LDSCTL_OFF))[u] = 0u;
    __syncthreads();
    XcdBarrier bar; bar.bar = (unsigned*)((unsigned char*)(GAS unsigned char*)args_k.ws + WS_CTL) + 4096; bar.x = 0; bar.st = nullptr;
    const int ph_lo = args_k.ph_lo, ph_hi = args_k.ph_hi;
    if (ph_hi - ph_lo > 1) bar = xcd_barrier_post((unsigned*)((unsigned char*)(GAS unsigned char*)args_k.ws + WS_CTL) + 4096, MISC + 8, t0_ == 0);

    STEP_BEGIN(0) phase_p0(args, lds, vcu, G, wave, lane, tid); STEP_END(0, true)
    STEP_BEGIN(1) DO_UP(0); DO_TAIL(CI_P0, CI_A); STEP_END(1, true)
    STEP_BEGIN(2) DO_DOWN(0); STEP_END(2, true)
    STEP_BEGIN(3) {
        pg8::Gemm g{(const bf16_t*)(ws + WS_XB), (const bf16_t*)(ws + WS_EVIN), DM, EVEN_IN, DM}; pg8::StaticOrder S; S.init(M, EVEN_IN, G, bx);
        pg8::EpiInEven E{(bf16_t*)(ws + WS_QKV), (const float*)(ws + WS_SSQ16), (const float*)(ws + WS_COSA), (const float*)(ws + WS_SINA)};
        pg8::gemm_phase(lds, g, S, E, pg8::RsSpec{(const float*)(ws + WS_SSQ16), 16, 1.0f / DM}, tid); } STEP_END(3, true)
    STEP_BEGIN(4) {
        const bf16_t* QKV = (const bf16_t*)(ws + WS_QKV); bf16_t* MIX = (bf16_t*)(ws + WS_MIX); float* SC = AOUT(args);
        const float* lf = AIN(args, I_DLAM);
        const float s1 = wave_sum(lf[lane] * lf[64 + lane]), s2 = wave_sum(lf[128 + lane] * lf[192 + lane]);
        const float lam = __expf(s1) - __expf(s2) + 0.2f;
#pragma unroll 1
        for (int ud = vcu; ud < 256; ud += G) { const int qb = ud & 15, h = (ud >> 4) & 3, b = ud >> 6;
            const size_t r0 = (size_t)b * SEQ;
            att::NAArgs na{0, nullptr};
            att::DiffArgs da{SC + (r0 + 256 * qb) * 512 + h * 128, lam, AIN(args, I_DSUB)};
            att::attn_unit<64, 128, false, 1>(QKV + (r0 + 256 * qb) * EVEN_IN + (2 * h) * 64, EVEN_IN, QKV + r0 * EVEN_IN + 512 + (2 * h) * 64, EVEN_IN, QKV + r0 * EVEN_IN + 1024 + h * 128, EVEN_IN,
                                              MIX + (r0 + 256 * qb) * 1024 + h * 128, 1024, 0, SEQ / 64, (LAS char*)lds, na, da, tid);
            att::attn_unit<64, 128, false, 2>(QKV + (r0 + 256 * qb) * EVEN_IN + (2 * h + 1) * 64, EVEN_IN, QKV + r0 * EVEN_IN + 512 + (2 * h + 1) * 64, EVEN_IN, QKV + r0 * EVEN_IN + 1024 + h * 128, EVEN_IN,
                                              MIX + (r0 + 256 * qb) * 1024 + h * 128, 1024, 0, SEQ / 64, (LAS char*)lds, na, da, tid); } } STEP_END(4, false)
    STEP_BEGIN(5) {
        const bf16_t* QKV = (const bf16_t*)(ws + WS_QKV); bf16_t* MIX = (bf16_t*)(ws + WS_MIX);
#pragma unroll 1
        for (int un0 = 2 * vcu; un0 < 512; un0 += 2 * G) for (int i = 0; i < 2; ++i) { const int un = un0 + i; const int qb = un & 15, h = (un >> 4) & 7, b = un >> 7;
            const size_t r0 = (size_t)b * SEQ;
            LAS float* rpbL = (LAS float*)(lds + att::Geo<64, 64>::RPBOFF);
            const float* rpb = AIN(args, I_RPB) + h * 465;
            for (int e = tid; e < 465; e += NWAVES * 64) rpbL[e] = rpb[e] * LOG2E;
            const int tlo = max(0, 4 * qb - 4), thi = min(64, 4 * qb + 8);
            att::NAArgs na{qb, rpbL};
            att::attn_unit<64, 64, true, 0>(QKV + (r0 + 256 * qb) * EVEN_IN + 1536 + h * 64, EVEN_IN, QKV + r0 * EVEN_IN + 2048 + h * 64, EVEN_IN, QKV + r0 * EVEN_IN + 2560 + h * 64, EVEN_IN,
                                         MIX + (r0 + 256 * qb) * 1024 + 512 + h * 64, 1024, tlo, thi - tlo, (LAS char*)lds, na, att::DiffArgs{nullptr, 0.f, nullptr}, tid); } } STEP_END(5, true)
    STEP_BEGIN(7) DO_OUT(0); STEP_END(7, true)
    STEP_BEGIN(8) DO_UP(1); DO_TAIL(CI_A, CI_B); STEP_END(8, true)
    STEP_BEGIN(9) DO_DOWN(1); STEP_END(9, true)
    STEP_BEGIN(10) DO_UP(2); DO_TAIL(CI_B, CI_C); STEP_END(10, true)
    STEP_BEGIN(11) DO_DOWN(2); STEP_END(11, true)
    STEP_BEGIN(12) {
        pg8::Gemm g{(const bf16_t*)(ws + WS_XB), (const bf16_t*)(ws + WS_ODIN), DM, ODD_INP, DM}; pg8::StaticOrder S; S.init(M, ODD_INP, G, bx);
        pg8::EpiInOdd E{(bf16_t*)(ws + WS_OD), (const float*)(ws + WS_SSQ16), (float*)(ws + WS_SSQCQ), (float*)(ws + WS_SSQCKV)};
        pg8::gemm_phase(lds, g, S, E, pg8::RsSpec{(const float*)(ws + WS_SSQ16), 16, 1.0f / DM}, tid); } STEP_END(12, true)
    STEP_BEGIN(13) {
#pragma unroll 1
        for (int uc = vcu; uc < 256; uc += G) rg_chunk<1>(args, lds, uc >> 6, uc & 63, wave, tid); } STEP_END(13, false)
    STEP_BEGIN(14) phase_kpe(args, vcu, G, wave, lane); STEP_END(14, false)
    STEP_BEGIN(15) {
        pg8::Gemm g{(const bf16_t*)(ws + WS_OD) + 1024, (const bf16_t*)(ws + WS_WUQ), ODD_INP, 768, 256}; pg8::StaticOrder S; S.init(M, 768, G, bx);
        pg8::EpiQup E{(bf16_t*)AOUT(args), (const float*)(ws + WS_SSQCQ), (const float*)(ws + WS_COSD), (const float*)(ws + WS_SIND)};
        pg8::gemm_phase(lds, g, S, E, pg8::RsSpec{(const float*)(ws + WS_SSQCQ), 4, 1.0f / 256.0f}, tid); } STEP_END(15, false)
    STEP_BEGIN(16) {
        pg8::Gemm g{(const bf16_t*)(ws + WS_OD) + 1280, (const bf16_t*)(ws + WS_WUKV), ODD_INP, 1024, 256}; pg8::StaticOrder S; S.init(M, 1024, G, bx);
        pg8::EpiKVup E{(bf16_t*)(ws + WS_KF), (bf16_t*)(ws + WS_VM), (const float*)(ws + WS_SSQCKV)};
        pg8::gemm_phase(lds, g, S, E, pg8::RsSpec{(const float*)(ws + WS_SSQCKV), 4, 1.0f / 128.0f}, tid); } STEP_END(16, true)
    STEP_BEGIN(17) {
        const bf16_t* QM = (const bf16_t*)AOUT(args);   const bf16_t* KF = (const bf16_t*)(ws + WS_KF); const bf16_t* VM = (const bf16_t*)(ws + WS_VM); bf16_t* MIX = (bf16_t*)(ws + WS_MIX);
#pragma unroll 1
        for (int um0 = 2 * vcu; um0 < 512; um0 += 2 * G) for (int i = 0; i < 2; ++i) { const int um = um0 + i; const int qb = um & 15, h = (um >> 4) & 7, b = um >> 7;
            const size_t r0 = (size_t)b * SEQ;
            att::NAArgs na{0, nullptr};
            att::attn_unit<96, 64, false, 0>(QM + (r0 + 256 * qb) * 768 + h * 96, 768, KF + r0 * 768 + h * 96, 768, VM + r0 * 512 + h * 64, 512,
                                          MIX + (r0 + 256 * qb) * 1024 + 512 + h * 64, 1024, 0, SEQ / 64, (LAS char*)lds, na, att::DiffArgs{nullptr, 0.f, nullptr}, tid); } } STEP_END(17, false)
    STEP_BEGIN(18) {
#pragma unroll 1
        for (int uc = vcu; uc < 256; uc += G) rg_chunk<2>(args, lds, uc >> 6, uc & 63, wave, tid); } STEP_END(18, true)
    STEP_BEGIN(19) DO_OUT(1); STEP_END(19, true)
    STEP_BEGIN(20) DO_UP(3); STEP_END(20, true)
    STEP_BEGIN(21) DO_DOWN(3); STEP_END(21, true)
    STEP_BEGIN(22) phase_final(args, vcu, G, wave, lane); STEP_END(22, false)
}

extern "C" void kernel_launch(void* const* d_in, const int* in_sizes, int n_in, void* d_out, int out_size, void* d_ws, size_t ws_size, hipStream_t stream) {
    static int grid = 0;
    if (grid == 0) {
        if (n_in != 29 || in_sizes[0] != M * DM || out_size != M * DM || ws_size < WS_END) {
            fprintf(stderr, "kernel_launch: unexpected shapes: n_in %d in0 %d out %d ws %zu (need %zu)\n", n_in, n_in > 0 ? in_sizes[0] : -1, out_size, ws_size, (size_t)WS_END); grid = -1; return; }
        int dev = 0, cus = 0;
        if (hipGetDevice(&dev) != hipSuccess || hipDeviceGetAttribute(&cus, hipDeviceAttributeMultiprocessorCount, dev) != hipSuccess) { fprintf(stderr, "kernel_launch: device query failed\n"); grid = -1; return; }
        if (hipFuncSetAttribute((const void*)mk_fwd, hipFuncAttributeMaxDynamicSharedMemorySize, LDS_BYTES) != hipSuccess) { fprintf(stderr, "kernel_launch: hipFuncSetAttribute failed\n"); grid = -1; return; }
        int per_cu = 0;
        if (hipOccupancyMaxActiveBlocksPerMultiprocessor(&per_cu, (const void*)mk_fwd, NWAVES * 64, LDS_BYTES) != hipSuccess || per_cu < 1)
            fprintf(stderr, "kernel_launch: note: occupancy query reports %d workgroups per CU\n", per_cu);
        (void)hipGetLastError();
        grid = cus;
        if (grid != 256) fprintf(stderr, "kernel_launch: note: %d CUs\n", grid);
    }
    if (grid < 0) return;
    (void)hipMemsetAsync((char*)d_ws + WS_CTL, 0, CTL_ZERO_BYTES, stream);
    Args a{};
    for (int i = 0; i < 29; ++i) a.in[i] = (const float*)d_in[i];
    a.out = (float*)d_out; a.ws = (unsigned char*)d_ws;
#if MK_ONE_LAUNCH
    a.ph_lo = 0; a.ph_hi = NSTEP;
    hipLaunchKernelGGL(mk_fwd, dim3(grid), dim3(NWAVES * 64), LDS_BYTES, stream, a);
#else
    for (int ph = 0; ph < NSTEP; ++ph) { a.ph_lo = ph; a.ph_hi = ph + 1; hipLaunchKernelGGL(mk_fwd, dim3(grid), dim3(NWAVES * 64), LDS_BYTES, stream, a); }
#endif
    const hipError_t le = hipPeekAtLastError();
    if (le != hipSuccess) fprintf(stderr, "kernel_launch: launch failed: %s\n", hipGetErrorName(le));
}
```

```cpp
#include <hip/hip_runtime.h>
#include <hip/hip_bf16.h>
#include <cstdio>
#include <cstdint>

#ifndef MK_ONE_LAUNCH
#define MK_ONE_LAUNCH 1
#endif

#define LAS __attribute__((address_space(3)))
#define GAS __attribute__((address_space(1)))
typedef unsigned short bf16_t;
typedef short bf16x8 __attribute__((ext_vector_type(8)));
typedef short s16x4 __attribute__((ext_vector_type(4)));
typedef float f32x2 __attribute__((ext_vector_type(2)));
typedef float f32x4 __attribute__((ext_vector_type(4)));
typedef float f32x16 __attribute__((ext_vector_type(16)));
typedef unsigned u32x2 __attribute__((ext_vector_type(2)));
typedef unsigned u32x4 __attribute__((ext_vector_type(4)));

constexpr int BATCH = 4, SEQ = 4096, DM = 1024, FF = 2816, M = BATCH * SEQ;
constexpr int EVEN_IN = 3072, ODD_IN = 1440, ODD_INP = 1536;
constexpr float RMS_EPS = 1e-6f;
constexpr float LOG2E = 1.4426950408889634f;
constexpr float QS64 = 0.125f * LOG2E;
constexpr float QS96 = 0.10206207261596577f * LOG2E;

constexpr size_t MiB = 1u << 20;
constexpr size_t WS_CTL = 0, CTL_ZERO_BYTES = 32 * 1024;
constexpr size_t WS_SSQ16 = 1 * MiB;
constexpr size_t WS_SSQCQ = 2 * MiB;
constexpr size_t WS_SSQCKV = 2 * MiB + 256 * 1024;
constexpr size_t WS_COSA = 2 * MiB + 512 * 1024;
constexpr size_t WS_SINA = 3 * MiB;
constexpr size_t WS_COSD = 3 * MiB + 512 * 1024;
constexpr size_t WS_SIND = 3 * MiB + 768 * 1024;
constexpr size_t WS_RGW = 4 * MiB;
constexpr size_t WS_SPT = 4 * MiB + 256 * 1024;
constexpr size_t WS_SUM = 5 * MiB;
constexpr size_t WS_W = 8 * MiB;
constexpr size_t SZ_WGU = (size_t)2 * FF * DM * 2, SZ_WD = (size_t)DM * FF * 2;
constexpr size_t WS_WGU = WS_W;
constexpr size_t WS_WD = WS_WGU + 4 * SZ_WGU;
constexpr size_t WS_EVIN = WS_WD + 4 * SZ_WD;
constexpr size_t WS_EVOUT = WS_EVIN + (size_t)EVEN_IN * DM * 2;
constexpr size_t WS_ODIN = WS_EVOUT + (size_t)DM * DM * 2;
constexpr size_t WS_ODOUT = WS_ODIN + (size_t)ODD_INP * DM * 2;
constexpr size_t WS_WUQ = WS_ODOUT + (size_t)DM * DM * 2;
constexpr size_t WS_WUKV = WS_WUQ + (size_t)768 * 256 * 2;
constexpr size_t WS_WEND = WS_WUKV + (size_t)1024 * 256 * 2;
constexpr size_t WS_XB = 88 * MiB;
constexpr size_t WS_BIG = 120 * MiB;
constexpr size_t WS_H = WS_BIG;
constexpr size_t WS_QKV = WS_BIG;
constexpr size_t WS_MIX = WS_BIG + 96 * MiB;
constexpr size_t WS_OD = WS_BIG;
constexpr size_t WS_KF = WS_BIG + 48 * MiB;
constexpr size_t WS_VM = WS_BIG + 72 * MiB;
constexpr size_t WS_OA = WS_XB;
constexpr size_t WS_QM = WS_XB;
constexpr size_t WS_END = 256 * MiB;
static_assert(WS_WEND <= WS_XB, "weights fit");
static_assert(WS_H + (size_t)M * FF * 2 <= WS_END && WS_MIX + (size_t)M * DM * 2 <= WS_END && WS_VM + (size_t)M * 512 * 2 <= WS_MIX, "ws map");

constexpr int RING_BYTES = 131072;
constexpr int LDSCTL_OFF = RING_BYTES, MISC_OFF = LDSCTL_OFF + 320;
constexpr int LDS_BYTES = 147456;
constexpr int RS_MAXU = 12;
constexpr int RS_OFF = RING_BYTES + 1024;
static_assert(RS_OFF + RS_MAXU * 256 * 4 <= LDS_BYTES, "rs table");
constexpr int NWAVES = 8;

typedef _Float16 h16x8 __attribute__((ext_vector_type(8)));
__device__ __forceinline__ unsigned cvt_pk_bf16(float lo, float hi) { unsigned r; asm volatile("v_cvt_pk_f16_f32 %0, %1, %2" : "=v"(r) : "v"(lo), "v"(hi)); return r; }
__device__ __forceinline__ float bf2f(bf16_t b) { return (float)__builtin_bit_cast(_Float16, b); }
__device__ __forceinline__ unsigned f2bf(float f) { return (unsigned)__builtin_bit_cast(unsigned short, (_Float16)f); }
#define MFMA16(a, b, c) __builtin_amdgcn_mfma_f32_16x16x32_f16(__builtin_bit_cast(h16x8, (a)), __builtin_bit_cast(h16x8, (b)), (c), 0, 0, 0)
#define MFMA32(a, b, c) __builtin_amdgcn_mfma_f32_32x32x16_f16(__builtin_bit_cast(h16x8, (a)), __builtin_bit_cast(h16x8, (b)), (c), 0, 0, 0)
__device__ __forceinline__ float wave_sum(float v) {
#pragma unroll
    for (int o = 1; o < 64; o <<= 1) v += __shfl_xor(v, o);
    return v;
}
__device__ __forceinline__ float sum16(const float* p) {
    const f32x4 a = ((const f32x4*)p)[0], b = ((const f32x4*)p)[1], c = ((const f32x4*)p)[2], d = ((const f32x4*)p)[3];
    return ((a.x + a.y) + (a.z + a.w)) + ((b.x + b.y) + (b.z + b.w)) + ((c.x + c.y) + (c.z + c.w)) + ((d.x + d.y) + (d.z + d.w));
}
__device__ __forceinline__ float sum4(const float* p) { const f32x4 a = *(const f32x4*)p; return (a.x + a.y) + (a.z + a.w); }
__device__ __forceinline__ float fast_sigmoid(float x) { return __builtin_amdgcn_rcpf(1.0f + __builtin_amdgcn_exp2f(-x * LOG2E)); }

namespace pg8 {
constexpr int BM = 256, BK = 64, HALF = 128, HTB = HALF * BK * 2, STAGE_BYTES = 8 * HTB, NXCD = 8, WGM = 8;
__host__ __device__ __forceinline__ int lds_byte(int r, int c) { const int st = (r >> 4) * 2 + (c >> 5), rr = r & 15, cc = c & 31, ob = rr * 64 + cc * 2; return st * 1024 + (ob ^ (((ob >> 9) & 1) << 5)); }
__host__ __device__ __forceinline__ void stage_rc(int b, int& R, int& C) { const int st = b / 1024, sb = b % 1024, swz = sb ^ (((sb >> 9) & 1) << 5); R = (st >> 1) * 16 + swz / 64; C = (st & 1) * 32 + (swz % 64) / 2; }
__host__ __device__ __forceinline__ int perm32(int rho) { const int n = rho >> 4, i = rho & 15; return 8 * (i >> 2) + 4 * n + (i & 3); }

struct Unit { int pm, pn; };
struct Gemm { const bf16_t* A; const bf16_t* Bt; int lda, N, K; };
struct RsSpec { const float* src; int nper; float invn; };

struct StaticOrder {
    int nM, nN, nwg, G, c;
    __device__ void init(int M_, int N, int G_, int c_) { nM = M_ / BM; nN = N / BM; nwg = nM * nN; G = G_; c = c_; }
    __device__ bool next(int i, Unit& u) const {
        const long L = (long)i * G + c; if (L >= nwg) return false;
        int wgid = (int)L; { const int q = nwg / NXCD, r = nwg % NXCD, xcd = wgid % NXCD, off = wgid / NXCD; wgid = (xcd < r ? xcd * (q + 1) : r * (q + 1) + (xcd - r) * q) + off; }
        const int nig = WGM * nN, gid = wgid / nig, fm = gid * WGM, gsz = (nM - fm) < WGM ? (nM - fm) : WGM;
        u.pm = fm + ((wgid % nig) % gsz); u.pn = (wgid % nig) / gsz; return true;
    }
};

template <class Epi>
__device__ __forceinline__ void gemm_phase(LAS unsigned char* lds, const Gemm g, const StaticOrder& S, const Epi& E, const RsSpec rsp, const int tid) {
    const int wid = __builtin_amdgcn_readfirstlane(tid >> 6), lane = tid & 63, wr = wid >> 2, wc = wid & 3, fr = lane & 15, fq = lane >> 4;
    int K_ = g.K, lda_ = g.lda; asm volatile("" : "+s"(K_), "+s"(lda_));
    const int K = K_, nt = K / BK, lda = lda_;
    unsigned voffA[2], voffB[2];
#pragma unroll
    for (int i = 0; i < 2; ++i) { int R, C; stage_rc(tid * 16 + i * 8192, R, C); const int Rb = Epi::PERM ? ((R & ~31) + perm32(R & 31)) : R;
        voffA[i] = (unsigned)(R * lda + C) * 2u; voffB[i] = (unsigned)(Rb * K + C) * 2u; }
    const size_t kstep = (size_t)(BK * 2);
    const size_t hstepA = (size_t)HALF * lda * 2, hstepB = (size_t)HALF * K * 2;
    const size_t tstepA = 2 * hstepA, tstepB = 2 * hstepB;
    const unsigned ldsw = (unsigned)wid * 1024u;
    const int aoff = lds_byte(wr * 64 + fr, fq * 8), boff = lds_byte(wc * 32 + fr, fq * 8);
#define PG8_SA(b, h) (((b) * 2 + (h)) * HTB)
#define PG8_SB(b, h) ((4 + (b) * 2 + (h)) * HTB)
#define PG8_STAGE(bufoff, gbase, voff) do { _Pragma("unroll") for (int _i = 0; _i < 2; ++_i) \
        __builtin_amdgcn_global_load_lds((const unsigned*)((const char*)(gbase) + (voff)[_i]), (LAS unsigned*)(lds + (bufoff) + ldsw + _i * 8192), 16, 0, 0); } while (0)
#define PG8_LDA(dst, b, h) do { _Pragma("unroll") for (int m = 0; m < 4; ++m) _Pragma("unroll") for (int k = 0; k < 2; ++k) dst[m][k] = *(const LAS bf16x8*)(lds + PG8_SA(b, h) + aoff + m * 2048 + k * 1024); } while (0)
#define PG8_LDB(dst, b, h) do { _Pragma("unroll") for (int n = 0; n < 2; ++n) _Pragma("unroll") for (int k = 0; k < 2; ++k) dst[n][k] = *(const LAS bf16x8*)(lds + PG8_SB(b, h) + boff + n * 2048 + k * 1024); } while (0)
#define PG8_MMA(ai, bj, At, Bt) do { __builtin_amdgcn_s_setprio(1); _Pragma("unroll") for (int m = 0; m < 4; ++m) _Pragma("unroll") for (int n = 0; n < 2; ++n) _Pragma("unroll") for (int k = 0; k < 2; ++k) \
        acc[ai][bj][m][n] = MFMA16(Bt[n][k], At[m][k], acc[ai][bj][m][n]); __builtin_amdgcn_s_setprio(0); } while (0)
#define PG8_WAIT_V(n) asm volatile("s_waitcnt vmcnt(" #n ")" ::: "memory")
#define PG8_WAIT_L(n) asm volatile("s_waitcnt lgkmcnt(" #n ")" ::: "memory")
#define PG8_BAR __builtin_amdgcn_s_barrier()
#define PG8_SCHED __builtin_amdgcn_sched_barrier(0)
    Unit cur, nxt; int ui = 0;
    if (!S.next(0, cur)) return;
    f32x4 acc[2][2][4][2];
#pragma unroll
    for (int a = 0; a < 2; ++a)
#pragma unroll
        for (int b = 0; b < 2; ++b)
#pragma unroll
            for (int m = 0; m < 4; ++m)
#pragma unroll
                for (int n = 0; n < 2; ++n) acc[a][b][m][n] = (f32x4){0.f, 0.f, 0.f, 0.f};
    bf16x8 At[4][2], B0[2][2], B1[2][2];
    const char* cA = (const char*)g.A + (size_t)cur.pm * tstepA; const char* cB = (const char*)g.Bt + (size_t)cur.pn * tstepB;
    PG8_STAGE(PG8_SB(0, 0), cB, voffB); PG8_STAGE(PG8_SB(0, 1), cB + hstepB, voffB); PG8_STAGE(PG8_SA(0, 0), cA, voffA); PG8_STAGE(PG8_SA(0, 1), cA + hstepA, voffA);
    LAS float* RS = (LAS float*)(lds + RS_OFF);
    if (rsp.src) {
#pragma unroll 1
        for (int i = 0; i < RS_MAXU; ++i) { Unit u; if (!S.next(i, u)) break;
            if (tid < 256) { const float* p = rsp.src + (size_t)(u.pm * BM + tid) * rsp.nper;
                const float sm = (rsp.nper == 16) ? sum16(p) : sum4(p);
                RS[i * 256 + tid] = rsqrtf(sm * rsp.invn + RMS_EPS); } }
        __syncthreads();
    }
    if (wr == 1) PG8_BAR;
    PG8_WAIT_V(2); PG8_BAR;
    PG8_STAGE(PG8_SB(1, 0), cB + kstep, voffB); PG8_STAGE(PG8_SA(1, 0), cA + kstep, voffA); PG8_STAGE(PG8_SB(1, 1), cB + hstepB + kstep, voffB);
    PG8_WAIT_V(6); PG8_BAR;
    for (;;) {
        const bool has_next = S.next(ui + 1, nxt);
        const char* nA = has_next ? (const char*)g.A + (size_t)nxt.pm * tstepA : cA; const char* nB = has_next ? (const char*)g.Bt + (size_t)nxt.pn * tstepB : cB;
        for (int t = 0; t < nt; t += 2) {
            const bool last = (t == nt - 2);
            const char* a1 = cA + (size_t)(t + 1) * kstep;
            const char* a2 = last ? nA : cA + (size_t)(t + 2) * kstep; const char* b2 = last ? nB : cB + (size_t)(t + 2) * kstep;
            const char* a3 = a2 + kstep; const char* b3 = b2 + kstep;
            PG8_LDB(B0, 0, 0); PG8_LDB(B1, 0, 1); PG8_SCHED; PG8_LDA(At, 0, 0); PG8_STAGE(PG8_SA(1, 1), a1 + hstepA, voffA);
            PG8_WAIT_V(8); PG8_WAIT_L(0); PG8_BAR; PG8_MMA(0, 0, At, B0); PG8_MMA(0, 1, At, B1); PG8_BAR; PG8_SCHED;
            PG8_LDA(At, 0, 1); PG8_STAGE(PG8_SB(0, 0), b2, voffB); PG8_STAGE(PG8_SB(0, 1), b2 + hstepB, voffB); PG8_STAGE(PG8_SA(0, 0), a2, voffA);
            PG8_WAIT_V(8); PG8_WAIT_L(0); PG8_BAR; PG8_MMA(1, 0, At, B0); PG8_MMA(1, 1, At, B1); PG8_BAR; PG8_SCHED;
            PG8_LDB(B0, 1, 0); PG8_LDB(B1, 1, 1); PG8_SCHED; PG8_LDA(At, 1, 0); PG8_STAGE(PG8_SA(0, 1), a2 + hstepA, voffA);
            PG8_WAIT_V(8); PG8_WAIT_L(0); PG8_BAR; PG8_MMA(0, 0, At, B0); PG8_MMA(0, 1, At, B1); PG8_BAR; PG8_SCHED;
            PG8_LDA(At, 1, 1); PG8_STAGE(PG8_SB(1, 0), b3, voffB); PG8_STAGE(PG8_SB(1, 1), b3 + hstepB, voffB); PG8_STAGE(PG8_SA(1, 0), a3, voffA);
            PG8_WAIT_V(8); PG8_WAIT_L(0); PG8_BAR; PG8_MMA(1, 0, At, B0); PG8_MMA(1, 1, At, B1); PG8_BAR; PG8_SCHED;
        }
        if (wr == 0) PG8_BAR;
        E(acc, cur, wr, wc, fr, fq, RS + ui * 256);
        if (!has_next) break;
#pragma unroll
        for (int a = 0; a < 2; ++a)
#pragma unroll
            for (int b = 0; b < 2; ++b)
#pragma unroll
                for (int m = 0; m < 4; ++m)
#pragma unroll
                    for (int n = 0; n < 2; ++n) acc[a][b][m][n] = (f32x4){0.f, 0.f, 0.f, 0.f};
        cur = nxt; cA = nA; cB = nB; ++ui;
        if (wr == 1) PG8_BAR;
    }
    PG8_WAIT_V(0);
    PG8_BAR;
#undef PG8_SA
#undef PG8_SB
#undef PG8_STAGE
#undef PG8_LDA
#undef PG8_LDB
#undef PG8_MMA
#undef PG8_WAIT_V
#undef PG8_WAIT_L
#undef PG8_BAR
#undef PG8_SCHED
}

__device__ __forceinline__ u32x4 pack8(const f32x4 a, const f32x4 b) { u32x4 w; w.x = cvt_pk_bf16(a[0], a[1]); w.y = cvt_pk_bf16(a[2], a[3]); w.z = cvt_pk_bf16(b[0], b[1]); w.w = cvt_pk_bf16(b[2], b[3]); return w; }

struct EpiSwiglu {
    static constexpr bool PERM = true;
    bf16_t* H; const float* ssq;
    __device__ __forceinline__ void operator()(const f32x4 (&acc)[2][2][4][2], const Unit& u, int wr, int wc, int fr, int fq, const LAS float* rs) const {
        const int row0 = u.pm * BM + wr * 64 + fr, col0 = u.pn * 128 + wc * 32 + 8 * fq;
#pragma unroll
        for (int ai = 0; ai < 2; ++ai)
#pragma unroll
            for (int m = 0; m < 4; ++m) {
                const int row = row0 + ai * HALF + m * 16;
                const float rstd = rs[ai * HALF + wr * 64 + m * 16 + fr];
                f32x4 h[2];
#pragma unroll
                for (int n = 0; n < 2; ++n) {
                    const f32x4 gt = acc[ai][0][m][n] * rstd, up = acc[ai][1][m][n] * rstd;
#pragma unroll
                    for (int e = 0; e < 4; ++e) h[n][e] = gt[e] * fast_sigmoid(gt[e]) * up[e];
                }
                *(u32x4*)(H + (size_t)row * FF + col0) = pack8(h[0], h[1]);
            }
    }
};

struct EpiResid {
    static constexpr bool PERM = false;
    bf16_t* xb; float* ssq; float alpha;
    __device__ __forceinline__ void operator()(const f32x4 (&acc)[2][2][4][2], const Unit& u, int wr, int wc, int fr, int fq, const LAS float* rs) const {
        const int row0 = u.pm * BM + wr * 64 + fr, col0 = u.pn * BM + wc * 32 + 4 * fq;
#pragma unroll
        for (int ai = 0; ai < 2; ++ai)
#pragma unroll
            for (int m = 0; m < 4; ++m) {
                const int row = row0 + ai * HALF + m * 16; const size_t off = (size_t)row * DM + col0; float s = 0.f;
                u32x2 rv[2][2];
#pragma unroll
                for (int bj = 0; bj < 2; ++bj)
#pragma unroll
                    for (int n = 0; n < 2; ++n) rv[bj][n] = *(const u32x2*)(xb + off + bj * HALF + n * 16);
#pragma unroll
                for (int bj = 0; bj < 2; ++bj)
#pragma unroll
                    for (int n = 0; n < 2; ++n) {
                        const f32x4 r = {bf2f((bf16_t)(rv[bj][n].x & 0xffffu)), bf2f((bf16_t)(rv[bj][n].x >> 16)), bf2f((bf16_t)(rv[bj][n].y & 0xffffu)), bf2f((bf16_t)(rv[bj][n].y >> 16))};
                        const f32x4 o = r + acc[ai][bj][m][n] * alpha;
                        s += (o[0] * o[0] + o[1] * o[1]) + (o[2] * o[2] + o[3] * o[3]);
                        u32x2 w; w.x = cvt_pk_bf16(o[0], o[1]); w.y = cvt_pk_bf16(o[2], o[3]);
                        *(u32x2*)(xb + off + bj * HALF + n * 16) = w;
                    }
                s += __shfl_xor(s, 16); s += __shfl_xor(s, 32);
                if (fq == 0) ssq[(size_t)row * 16 + u.pn * 4 + wc] = s;
            }
    }
};

struct EpiInEven {
    static constexpr bool PERM = true;
    bf16_t* QKV; const float* ssq; const float* cosA; const float* sinA;
    __device__ __forceinline__ void operator()(const f32x4 (&acc)[2][2][4][2], const Unit& u, int wr, int wc, int fr, int fq, const LAS float* rs) const {
        const int row0 = u.pm * BM + wr * 64 + fr, pn = u.pn;
        const bool rope = pn < 4;
        const float sc = (pn < 2 || pn == 6 || pn == 7) ? QS64 : 1.0f;
#pragma unroll
        for (int ai = 0; ai < 2; ++ai)
#pragma unroll
            for (int m = 0; m < 4; ++m) {
                const int row = row0 + ai * HALF + m * 16;
                const float rsv = rs[ai * HALF + wr * 64 + m * 16 + fr] * sc;
                bf16_t* rowp = QKV + (size_t)row * EVEN_IN + pn * BM;
                if (rope) {
                    const int pos = row & (SEQ - 1);
                    const float* cp = cosA + pos * 32 + 8 * fq; const float* sp = sinA + pos * 32 + 8 * fq;
                    f32x4 o1[2], o2[2];
#pragma unroll
                    for (int n = 0; n < 2; ++n) {
                        const f32x4 c = *(const f32x4*)(cp + 4 * n), s = *(const f32x4*)(sp + 4 * n);
                        const f32x4 x1 = acc[ai][0][m][n] * rsv, x2 = acc[ai][1][m][n] * rsv;
                        o1[n] = x1 * c - x2 * s; o2[n] = x1 * s + x2 * c;
                    }
                    *(u32x4*)(rowp + 64 * wc + 8 * fq) = pack8(o1[0], o1[1]);
                    *(u32x4*)(rowp + 64 * wc + 32 + 8 * fq) = pack8(o2[0], o2[1]);
                } else {
#pragma unroll
                    for (int bj = 0; bj < 2; ++bj)
                        *(u32x4*)(rowp + bj * HALF + wc * 32 + 8 * fq) = pack8(acc[ai][bj][m][0] * rsv, acc[ai][bj][m][1] * rsv);
                }
            }
    }
};

struct EpiInOdd {
    static constexpr bool PERM = true;
    bf16_t* OD; const float* ssq; float* ssq_cq; float* ssq_ckv;
    __device__ __forceinline__ void operator()(const f32x4 (&acc)[2][2][4][2], const Unit& u, int wr, int wc, int fr, int fq, const LAS float* rs) const {
        const int row0 = u.pm * BM + wr * 64 + fr, pn = u.pn;
#pragma unroll
        for (int ai = 0; ai < 2; ++ai)
#pragma unroll
            for (int m = 0; m < 4; ++m) {
                const int row = row0 + ai * HALF + m * 16;
                const float rsv = rs[ai * HALF + wr * 64 + m * 16 + fr];
                bf16_t* rowp = OD + (size_t)row * ODD_INP + pn * BM;
                float s0 = 0.f, s1 = 0.f;
#pragma unroll
                for (int bj = 0; bj < 2; ++bj) {
                    const f32x4 a = acc[ai][bj][m][0] * rsv, b = acc[ai][bj][m][1] * rsv;
                    *(u32x4*)(rowp + bj * HALF + wc * 32 + 8 * fq) = pack8(a, b);
                    const float q = ((a[0] * a[0] + a[1] * a[1]) + (a[2] * a[2] + a[3] * a[3])) + ((b[0] * b[0] + b[1] * b[1]) + (b[2] * b[2] + b[3] * b[3]));
                    if (bj == 0) s0 = q; else s1 = q;
                }
                if (pn == 4 || pn == 5) {
                    float s = (pn == 4) ? (s0 + s1) : s0;
                    s += __shfl_xor(s, 16); s += __shfl_xor(s, 32);
                    if (fq == 0) { if (pn == 4) ssq_cq[(size_t)row * 4 + wc] = s; else ssq_ckv[(size_t)row * 4 + wc] = s; }
                }
            }
    }
};

struct EpiQup {
    static constexpr bool PERM = true;
    bf16_t* Qm; const float* ssq_cq; const float* cosD; const float* sinD;
    __device__ __forceinline__ void operator()(const f32x4 (&acc)[2][2][4][2], const Unit& u, int wr, int wc, int fr, int fq, const LAS float* rs) const {
        const int row0 = u.pm * BM + wr * 64 + fr, pn = u.pn;
#pragma unroll
        for (int ai = 0; ai < 2; ++ai)
#pragma unroll
            for (int m = 0; m < 4; ++m) {
                const int row = row0 + ai * HALF + m * 16;
                const float rsv = rs[ai * HALF + wr * 64 + m * 16 + fr] * QS96;
                bf16_t* rowp = Qm + (size_t)row * 768;
                if (pn == 2) {
                    const int pos = row & (SEQ - 1), head = 2 * wc + (fq >> 1), d0 = 8 * (fq & 1);
                    const float* cp = cosD + pos * 16 + d0; const float* sp = sinD + pos * 16 + d0;
                    f32x4 o1[2], o2[2];
#pragma unroll
                    for (int n = 0; n < 2; ++n) {
                        const f32x4 c = *(const f32x4*)(cp + 4 * n), s = *(const f32x4*)(sp + 4 * n);
                        const f32x4 x1 = acc[ai][0][m][n] * rsv, x2 = acc[ai][1][m][n] * rsv;
                        o1[n] = x1 * c - x2 * s; o2[n] = x1 * s + x2 * c;
                    }
                    *(u32x4*)(rowp + head * 96 + 64 + d0) = pack8(o1[0], o1[1]);
                    *(u32x4*)(rowp + head * 96 + 80 + d0) = pack8(o2[0], o2[1]);
                } else {
#pragma unroll
                    for (int bj = 0; bj < 2; ++bj) {
                        const int c = pn * BM + bj * HALF + wc * 32 + 8 * fq, h = c >> 6, d = c & 63;
                        *(u32x4*)(rowp + h * 96 + d) = pack8(acc[ai][bj][m][0] * rsv, acc[ai][bj][m][1] * rsv);
                    }
                }
            }
    }
};

struct EpiKVup {
    static constexpr bool PERM = true;
    bf16_t* Kf; bf16_t* Vm; const float* ssq_ckv;
    __device__ __forceinline__ void operator()(const f32x4 (&acc)[2][2][4][2], const Unit& u, int wr, int wc, int fr, int fq, const LAS float* rs) const {
        const int row0 = u.pm * BM + wr * 64 + fr, pn = u.pn;
#pragma unroll
        for (int ai = 0; ai < 2; ++ai)
#pragma unroll
            for (int m = 0; m < 4; ++m) {
                const int row = row0 + ai * HALF + m * 16;
                const float rsv = rs[ai * HALF + wr * 64 + m * 16 + fr];
#pragma unroll
                for (int bj = 0; bj < 2; ++bj) {
                    const int h = 2 * pn + bj, j = wc * 32 + 8 * fq;
                    bf16_t* dst = (wc < 2) ? (Kf + (size_t)row * 768 + h * 96 + j) : (Vm + (size_t)row * 512 + h * 64 + (j - 64));
                    *(u32x4*)dst = pack8(acc[ai][bj][m][0] * rsv, acc[ai][bj][m][1] * rsv);
                }
            }
    }
};
}

namespace att {
constexpr int NW = 8, QBLK = 32, KVBLK = 64;
constexpr float THR2 = 8.f;
#define SBAR() __builtin_amdgcn_sched_barrier(0)
__device__ __forceinline__ int crow(int r, int hi) { return (r & 3) + 8 * (r >> 2) + 4 * hi; }
template <int DK> struct KGeo { static constexpr int ROWB = DK * 2 + 16, BYTES = 64 * ROWB; };
template <int DV> struct VGeo { static constexpr int NCB = DV / 32, BYTES = 64 * DV * 2; };
template <int DK, int DV> struct Geo { static constexpr int KOFF = 2 * VGeo<DV>::BYTES, WSOFF = KOFF + 2 * KGeo<DK>::BYTES, RPBOFF = WSOFF + NW * 64 * 4, BYTES = RPBOFF + 2048; };

struct NAArgs { int qb; const LAS float* rpb; };

__device__ __forceinline__ void partialSM(f32x16& p0, f32x16& p1, float& m_reg, f32x16& negm, float& alpha, bool& first) {
    float pmax = p0[0];
#pragma unroll
    for (int r = 1; r < 16; ++r) pmax = fmaxf(pmax, p0[r]);
#pragma unroll
    for (int r = 0; r < 16; ++r) pmax = fmaxf(pmax, p1[r]);
    { auto rr = __builtin_amdgcn_permlane32_swap(__float_as_uint(pmax), __float_as_uint(pmax), false, false);
      pmax = fmaxf(__uint_as_float(rr[0]), __uint_as_float(rr[1])); }
    if (__builtin_expect(!first && __all(pmax <= THR2), 1)) { alpha = 1.f; }
    else {
        const float dl = first ? ((pmax == -INFINITY) ? 0.f : pmax) : fmaxf(pmax, 0.f);
        alpha = first ? 0.f : __builtin_amdgcn_exp2f(-dl); m_reg += dl; first = false;
#pragma unroll
        for (int r = 0; r < 16; ++r) { p0[r] = p0[r] - dl; p1[r] = p1[r] - dl; }
#pragma unroll
        for (int r = 0; r < 16; ++r) negm[r] = -m_reg;
        asm volatile("" : "+v"(negm));
    }
#pragma unroll
    for (int r = 0; r < 16; ++r) p0[r] = __builtin_amdgcn_exp2f(p0[r]);
}
__device__ __forceinline__ void finishSM(f32x16& p0, f32x16& p1, float alpha, float& l_reg, bf16x8& pa0, bf16x8& pa1, bf16x8& pa2, bf16x8& pa3) {
#pragma unroll
    for (int r = 0; r < 16; ++r) p1[r] = __builtin_amdgcn_exp2f(p1[r]);
    float ps = 0;
#pragma unroll
    for (int r = 0; r < 16; ++r) ps += p0[r];
#pragma unroll
    for (int r = 0; r < 16; ++r) ps += p1[r];
    { auto rr = __builtin_amdgcn_permlane32_swap(__float_as_uint(ps), __float_as_uint(ps), false, false);
      ps = __uint_as_float(rr[0]) + __uint_as_float(rr[1]); }
    l_reg = l_reg * alpha + ps;
#define PK4(P, BASE, OUT) do { unsigned a0 = cvt_pk_bf16(P[BASE + 0], P[BASE + 1]), a1 = cvt_pk_bf16(P[BASE + 2], P[BASE + 3]);   \
    unsigned b0 = cvt_pk_bf16(P[BASE + 4], P[BASE + 5]), b1 = cvt_pk_bf16(P[BASE + 6], P[BASE + 7]);                              \
    auto r0 = __builtin_amdgcn_permlane32_swap(a0, b0, false, false); auto r1 = __builtin_amdgcn_permlane32_swap(a1, b1, false, false); \
    u32x4 w = {r0[0], r1[0], r0[1], r1[1]}; OUT = __builtin_bit_cast(bf16x8, w); } while (0)
    PK4(p0, 0, pa0); PK4(p0, 8, pa1); PK4(p1, 0, pa2); PK4(p1, 8, pa3);
#undef PK4
}
template <int DK>
__device__ __forceinline__ void qkt(f32x16& p0, f32x16& p1, const LAS char* Ks, const bf16x8* qr, int r32, int hi, const f32x16& negm) {
    p0 = negm; p1 = negm;
#pragma unroll
    for (int d0 = 0; d0 < DK / 16; ++d0) { const int cb = (d0 * 16 + hi * 8) * 2;
        const bf16x8 b0 = *(const LAS bf16x8*)(Ks + r32 * KGeo<DK>::ROWB + cb);
        const bf16x8 b1 = *(const LAS bf16x8*)(Ks + (32 + r32) * KGeo<DK>::ROWB + cb);
        p0 = MFMA32(b0, qr[d0], p0);
        p1 = MFMA32(b1, qr[d0], p1); }
}
template <int DV> __device__ __forceinline__ int v_st(int k, int c) { const int kk = (k & ~0xC) | ((k & 4) << 1) | ((k & 8) >> 1); return ((kk >> 3) * VGeo<DV>::NCB + (c >> 5)) * 512 + ((kk & 7) * 32 + (c & 31)) * 2; }
__device__ __forceinline__ int v_rd_base(int lane) { return ((lane & 3) << 3) | (((lane >> 2) & 3) << 6) | (((lane >> 4) & 1) << 5) | (((lane >> 5) & 1) << 8); }
template <int DV> constexpr int v_rd_off(int d0, int ks, int half) { return ((2 * ks + half) * VGeo<DV>::NCB + d0) * 512; }
template <int OFF> __device__ __forceinline__ s16x4 tr_read(int vb) { s16x4 r; asm volatile("ds_read_b64_tr_b16 %0, %1 offset:%2" : "=&v"(r) : "v"(vb), "i"(OFF) : "memory"); return r; }
template <int DV, int D0> __device__ __forceinline__ void pv_one(f32x16& od, int vb, bf16x8 pa0, bf16x8 pa1, bf16x8 pa2, bf16x8 pa3) {
    const s16x4 l0 = tr_read<v_rd_off<DV>(D0, 0, 0)>(vb), h0 = tr_read<v_rd_off<DV>(D0, 0, 1)>(vb), l1 = tr_read<v_rd_off<DV>(D0, 1, 0)>(vb), h1 = tr_read<v_rd_off<DV>(D0, 1, 1)>(vb);
    const s16x4 l2 = tr_read<v_rd_off<DV>(D0, 2, 0)>(vb), h2 = tr_read<v_rd_off<DV>(D0, 2, 1)>(vb), l3 = tr_read<v_rd_off<DV>(D0, 3, 0)>(vb), h3 = tr_read<v_rd_off<DV>(D0, 3, 1)>(vb);
    asm volatile("s_waitcnt lgkmcnt(0)" ::: "memory"); SBAR();
#define PK(L, H) (bf16x8){L[0], L[1], L[2], L[3], H[0], H[1], H[2], H[3]}
    od = MFMA32(pa0, PK(l0, h0), od);
    od = MFMA32(pa1, PK(l1, h1), od);
    od = MFMA32(pa2, PK(l2, h2), od);
    od = MFMA32(pa3, PK(l3, h3), od);
#undef PK
}
template <int DV> __device__ __forceinline__ void pv_all(f32x16* o, int vb, bf16x8 pa0, bf16x8 pa1, bf16x8 pa2, bf16x8 pa3) {
    pv_one<DV, 0>(o[0], vb, pa0, pa1, pa2, pa3); pv_one<DV, 1>(o[1], vb, pa0, pa1, pa2, pa3);
    if constexpr (DV == 128) { pv_one<DV, 2>(o[2], vb, pa0, pa1, pa2, pa3); pv_one<DV, 3>(o[3], vb, pa0, pa1, pa2, pa3); }
}
__device__ __forceinline__ void na_bias(f32x16& p0, f32x16& p1, int kr, int rq, int cq, int hi, const LAS float* rpb) {
    const int r0q = min(max(rq - 4, 0), 56);
    const bool vrow = (kr >= r0q) && (kr < r0q + 8);
    const LAS float* rowp = rpb + (vrow ? (kr - rq + 7) : 0) * 31;
    const int c0 = min(max(cq - 8, 0), 48);
    const float NEG = -INFINITY;
#pragma unroll
    for (int r = 0; r < 16; ++r) {
        const int ck0 = crow(r, hi), ck1 = ck0 + 32;
        const bool ok0 = vrow && (ck0 >= c0) && (ck0 < c0 + 16), ok1 = vrow && (ck1 >= c0) && (ck1 < c0 + 16);
        const int i0 = min(max(ck0 - cq, -15), 15) + 15, i1 = min(max(ck1 - cq, -15), 15) + 15;
        const float b0 = rowp[i0], b1 = rowp[i1];
        p0[r] = ok0 ? p0[r] + b0 : NEG; p1[r] = ok1 ? p1[r] + b1 : NEG;
    }
}

struct DiffArgs { float* Sc; float lam; const float* g; };
template <int DK, int DV, bool NA, int EPI>
__device__ __forceinline__ void attn_unit(const bf16_t* Qb, int ldq, const bf16_t* Kh, int ldk, const bf16_t* Vh, int ldv, bf16_t* Ob, int ldo,
                                          int t0, int NT, LAS char* lds, const NAArgs na, const DiffArgs da, const int tid_in) {
    int tid = tid_in; asm volatile("" : "+v"(tid));
    constexpr int KROWB = KGeo<DK>::ROWB, KBYTES = KGeo<DK>::BYTES, VBYTES = VGeo<DV>::BYTES, NO = DV / 32;
    const int wid = __builtin_amdgcn_readfirstlane(tid >> 6), lane = tid & 63, r32 = lane & 31, hi = lane >> 5;
    LAS char* V_lds = lds; LAS char* K_lds = lds + Geo<DK, DV>::KOFF;
    LAS float* ws = (LAS float*)(lds + Geo<DK, DV>::WSOFF) + wid * 64; LAS float* li_l = ws; LAS float* al_l = ws + 32;
    float m_reg = 0.f, l_reg = 0; f32x16 o[NO]; bf16x8 qr[DK / 16]; f32x16 negm = f32x16{}; bool first = true;
#pragma unroll
    for (int d = 0; d < NO; ++d) o[d] = f32x16{};
    const bf16_t* Qw = Qb + (size_t)(wid * QBLK + r32) * ldq + hi * 8;
#pragma unroll
    for (int d0 = 0; d0 < DK / 16; ++d0) qr[d0] = *(const bf16x8*)(Qw + d0 * 16);
    int krow0, kch0, krow1 = 0, kch1 = 0;
    if constexpr (DK == 64) { krow0 = tid >> 3; kch0 = tid & 7; }
    else { krow0 = tid / 12; kch0 = tid % 12; const int i1 = tid + 512; krow1 = i1 / 12; kch1 = i1 % 12; }
    const bool k2 = (DK == 96) && (tid < 256);
    int vrow0, vcol0;
    if constexpr (DV == 64) { vrow0 = tid >> 3; vcol0 = (tid & 7) * 8; } else { vrow0 = tid >> 4; vcol0 = (tid & 15) * 8; }
    const int vst0 = v_st<DV>(vrow0, vcol0), vst1 = v_st<DV>(32 + vrow0, vcol0);
    const int vb0 = (int)(uintptr_t)V_lds + v_rd_base(lane);
    bf16x8 ks0, ks1, vs0, vs1;
#define SLOAD(kk) do { const size_t k0_ = (size_t)(kk); ks0 = *(const bf16x8*)(Kh + (k0_ + krow0) * ldk + kch0 * 8); \
        if (k2) ks1 = *(const bf16x8*)(Kh + (k0_ + krow1) * ldk + kch1 * 8); \
        vs0 = *(const bf16x8*)(Vh + (k0_ + vrow0) * ldv + vcol0); \
        if constexpr (DV == 128) vs1 = *(const bf16x8*)(Vh + (k0_ + 32 + vrow0) * ldv + vcol0); } while (0)
#define SWRITE(b) do { *(LAS bf16x8*)(K_lds + (b) * KBYTES + krow0 * KROWB + kch0 * 16) = ks0; \
        if (k2) *(LAS bf16x8*)(K_lds + (b) * KBYTES + krow1 * KROWB + kch1 * 16) = ks1; \
        *(LAS bf16x8*)(V_lds + (b) * VBYTES + vst0) = vs0; \
        if constexpr (DV == 128) *(LAS bf16x8*)(V_lds + (b) * VBYTES + vst1) = vs1; } while (0)
#define RESC(a) do { if (__any((a) < 1.f)) { if (hi == 0) al_l[r32] = (a); asm volatile("s_waitcnt lgkmcnt(0)" ::: "memory"); \
        _Pragma("unroll") for (int d = 0; d < NO; ++d) _Pragma("unroll") for (int r = 0; r < 16; ++r) o[d][r] *= al_l[crow(r, hi)]; } } while (0)
    const int rq = NA ? (4 * na.qb + (wid >> 1)) : 0, cq = NA ? (32 * (wid & 1) + r32) : 0;
    const int r0q_ = NA ? min(max(rq - 4, 0), 56) : 0;
    bool vA = true, vB = true;
#define QKT(P0, P1, KB, t, VF) do { if constexpr (NA) { VF = ((t) >= r0q_) && ((t) < r0q_ + 8); \
        if (VF) { qkt<DK>(P0, P1, KB, qr, r32, hi, negm); na_bias(P0, P1, (t), rq, cq, hi, na.rpb); } \
        else { _Pragma("unroll") for (int r_ = 0; r_ < 16; ++r_) { P0[r_] = -INFINITY; P1[r_] = -INFINITY; } } } \
      else { qkt<DK>(P0, P1, KB, qr, r32, hi, negm); } } while (0)
#define PV(VOFF, VF) do { if (!NA || (VF)) pv_all<DV>(o, vb0 + (VOFF), pa0, pa1, pa2, pa3); } while (0)
#define PSM(P0, P1, MN, AL, VF) do { if (!NA || (VF)) partialSM(P0, P1, m_reg, negm, AL, first); else { AL = 1.f; } } while (0)
#define FSM(P0, P1, AL, VF) do { if (!NA || (VF)) finishSM(P0, P1, AL, l_reg, pa0, pa1, pa2, pa3); } while (0)
    f32x16 pA0, pA1, pB0, pB1; float mnA, mnB, alA, alB; bf16x8 pa0, pa1, pa2, pa3;
    const int kbase = t0 * KVBLK;
    SLOAD(kbase); SWRITE(0); __syncthreads();
    QKT(pA0, pA1, K_lds, t0, vA); PSM(pA0, pA1, mnA, alA, vA);
    SLOAD(kbase + KVBLK); SWRITE(1); __syncthreads();
    for (int j = 1; j + 1 < NT; j += 2) {
        SBAR(); QKT(pB0, pB1, K_lds + KBYTES, t0 + j, vB);
        FSM(pA0, pA1, alA, vA); SBAR();
        SLOAD(kbase + (j + 1) * KVBLK); SBAR();
        PV(0, vA); PSM(pB0, pB1, mnB, alB, vB);
        __syncthreads(); SWRITE(0);
        RESC(alB); __syncthreads();
        SBAR(); QKT(pA0, pA1, K_lds, t0 + j + 1, vA);
        FSM(pB0, pB1, alB, vB); SBAR();
        SLOAD(kbase + (j + 2) * KVBLK); SBAR();
        PV(VBYTES, vB); PSM(pA0, pA1, mnA, alA, vA);
        __syncthreads(); SWRITE(1);
        RESC(alA); __syncthreads();
    }
    SBAR(); QKT(pB0, pB1, K_lds + KBYTES, t0 + NT - 1, vB);
    FSM(pA0, pA1, alA, vA); SBAR();
    PV(0, vA); PSM(pB0, pB1, mnB, alB, vB);
    __syncthreads(); RESC(alB);
    FSM(pB0, pB1, alB, vB); SBAR();
    PV(VBYTES, vB);
    if (hi == 0) li_l[r32] = l_reg; asm volatile("s_waitcnt lgkmcnt(0)" ::: "memory");
    int l2 = lane; asm volatile("" : "+v"(l2));
    const int r32e = l2 & 31, hie = l2 >> 5;
    float rli[16];
#pragma unroll
    for (int r = 0; r < 16; ++r) rli[r] = __builtin_amdgcn_rcpf(li_l[crow(r, hie)]);
    bf16_t* Ow = Ob + (size_t)(wid * QBLK + 4 * hie) * ldo + r32e;
    if constexpr (EPI == 0) {
#pragma unroll
        for (int r = 0; r < 16; ++r) { const int orow = (r & 3) + 8 * (r >> 2);
#pragma unroll
            for (int d0 = 0; d0 < NO; ++d0) Ow[orow * ldo + d0 * 32] = (bf16_t)f2bf(o[d0][r] * rli[r]); }
    } else {
        float* Sw = da.Sc + (size_t)(wid * QBLK + 4 * hie) * 512 + r32e;
        if constexpr (EPI == 1) {
#pragma unroll
            for (int r = 0; r < 16; ++r) { const int orow = (r & 3) + 8 * (r >> 2);
#pragma unroll
                for (int d0 = 0; d0 < NO; ++d0) Sw[orow * 512 + d0 * 32] = o[d0][r] * rli[r]; }
        } else {
            float gg[NO];
#pragma unroll
            for (int d0 = 0; d0 < NO; ++d0) gg[d0] = da.g[d0 * 32 + r32e] * 0.8f;
#pragma unroll
            for (int r = 0; r < 16; ++r) { const int orow = (r & 3) + 8 * (r >> 2);
                float v[NO]; float sq = 0.f;
#pragma unroll
                for (int d0 = 0; d0 < NO; ++d0) { v[d0] = Sw[orow * 512 + d0 * 32] - da.lam * (o[d0][r] * rli[r]); sq += v[d0] * v[d0]; }
                sq += __shfl_xor(sq, 1); sq += __shfl_xor(sq, 2); sq += __shfl_xor(sq, 4); sq += __shfl_xor(sq, 8); sq += __shfl_xor(sq, 16);
                const float rs = rsqrtf(sq * (1.0f / 128.0f) + RMS_EPS);
#pragma unroll
                for (int d0 = 0; d0 < NO; ++d0) Ow[orow * ldo + d0 * 32] = (bf16_t)f2bf(v[d0] * rs * gg[d0]); }
        }
    }
    __syncthreads();
#undef SLOAD
#undef SWRITE
#undef RESC
#undef QKT
#undef PV
#undef PSM
#undef FSM
}
#undef SBAR
}

typedef GAS unsigned gu32;
#define RLX_AGENT __ATOMIC_RELAXED, __HIP_MEMORY_SCOPE_AGENT
#define XB_TMO      128
#define XB_XCNT(j)  (256  + 64 * (j))
#define XB_XSUB(j)  (1280 + 64 * (j))
#define XB_XGEN(j)  (2304 + 64 * (j))
#define XB_TOP      3328
#define XB_TOPGEN   3392
#define XCD_BAR_WORDS 3456
#define XB_SPIN_CAP (1u << 18)
__device__ __forceinline__ unsigned xb_ld(unsigned* p)              { return __hip_atomic_load(p, __ATOMIC_RELAXED, __HIP_MEMORY_SCOPE_AGENT); }
__device__ __forceinline__ unsigned xb_add(unsigned* p, unsigned v) { return __hip_atomic_fetch_add(p, v, __ATOMIC_RELAXED, __HIP_MEMORY_SCOPE_AGENT); }
__device__ __forceinline__ unsigned xb_xcc_id() { return (unsigned)__builtin_amdgcn_s_getreg((3 << 11) | 20) & 0xFu; }
#define XB_SPIN(cond, bar) do { unsigned _sp = 0; while (cond) { __builtin_amdgcn_s_sleep(1); \
    if ((++_sp & 255u) == 0u) { if (xb_ld(&(bar)[XB_TMO])) break; if (_sp > XB_SPIN_CAP) { atomicAdd(&(bar)[XB_TMO], 1u); break; } } } } while (0)
struct XcdBarrier { unsigned* bar; unsigned x; volatile LAS unsigned* st; };
__device__ __forceinline__ XcdBarrier xcd_barrier_post(unsigned* bar, volatile LAS unsigned* st, bool leader) {
    XcdBarrier b; b.bar = bar; b.x = xb_xcc_id(); b.st = st;
    if (leader) (void)xb_add(&bar[XB_XCNT(b.x)], 1u);
    return b;
}
__device__ __forceinline__ void xcd_barrier_complete(unsigned* bar, unsigned x, unsigned& nloc, unsigned& nx) {
    const unsigned G = gridDim.x * gridDim.y * gridDim.z;
    unsigned sum, cnt, mine, sp = 0u;
    for (;;) {
        sum = 0u; cnt = 0u; mine = 0u;
#pragma unroll
        for (unsigned j = 0; j < 16; ++j) { const unsigned c = xb_ld(&bar[XB_XCNT(j)]); sum += c; cnt += (c > 0u) ? 1u : 0u; mine = (j == x) ? c : mine; }
        if (sum == G) break;
        __builtin_amdgcn_s_sleep(1);
        if ((++sp & 255u) == 0u) { if (xb_ld(&bar[XB_TMO])) break; if (sp > XB_SPIN_CAP) { atomicAdd(&bar[XB_TMO], 1u); break; } }
    }
    nloc = mine > 0u ? mine : 1u; nx = cnt > 0u ? cnt : 1u;
}
__device__ __forceinline__ void xcd_barrier(const XcdBarrier& b, bool leader) {
    asm volatile("s_waitcnt vmcnt(0)" ::: "memory");
    __syncthreads();
    if (leader) {
        unsigned* bar = b.bar;
        __builtin_amdgcn_s_waitcnt(0);
        unsigned nloc = b.st[0], nx = b.st[1];
        if (nloc == 0u) { xcd_barrier_complete(bar, b.x, nloc, nx); b.st[0] = nloc; b.st[1] = nx; }
        const unsigned old = xb_add(&bar[XB_XSUB(b.x)], 1u);
        const unsigned gen = old / nloc;
        if (old + 1u == (gen + 1u) * nloc) {
            __builtin_amdgcn_fence(__ATOMIC_RELEASE, "agent");
            asm volatile("s_waitcnt vmcnt(0)" ::: "memory");
            const unsigned og = xb_add(&bar[XB_TOP], 1u);
            const unsigned tg = og / nx;
            if (og + 1u == (tg + 1u) * nx) xb_add(&bar[XB_TOPGEN], 1u);
            else XB_SPIN(xb_ld(&bar[XB_TOPGEN]) == tg, bar);
            __builtin_amdgcn_fence(__ATOMIC_ACQUIRE, "agent");
            xb_add(&bar[XB_XGEN(b.x)], 1u);
            asm volatile("s_waitcnt vmcnt(0)" ::: "memory");
        } else {
            XB_SPIN(xb_ld(&bar[XB_XGEN(b.x)]) == gen, bar);
            __builtin_amdgcn_fence(__ATOMIC_ACQUIRE, "agent");
            asm volatile("s_waitcnt vmcnt(0)" ::: "memory");
        }
    }
    __syncthreads();
}

struct Args { const float* in[29]; float* out; unsigned char* ws; int ph_lo, ph_hi; };
typedef const __attribute__((address_space(4))) Args* ArgsP;
#define AIN(a, i) ((const float*)(const GAS float*)((a)->in[i]))
#define AOUT(a) ((float*)(GAS float*)((a)->out))
#define AWS(a) ((unsigned char*)(GAS unsigned char*)((a)->ws))
enum { I_X = 0, I_F1N, I_F1G, I_F1U, I_F1D, I_MIXN, I_F2N, I_F2G, I_F2U, I_F2D, I_FINN, I_EVIN, I_EVOUT, I_DLAM, I_DSUB, I_RPB, I_ODIN, I_ODOUT,
       I_CONVW, I_CONVB, I_RGWA, I_RGBA, I_RGWX, I_RGBX, I_RGLAM, I_GQ, I_GKV, I_WUQ, I_WUKV };


template <class ColPtr>
__device__ __forceinline__ void conv_item(int ldw, int K, bf16_t* WT, const float* gain, LAS bf16_t* T, int kb, int nb, int lane, ColPtr colptr) {
    const int k0 = 64 * kb, n0 = 64 * nb, cg = (lane & 15) * 4, rl = lane >> 4;
    const float* src = colptr(n0 + cg);
    f32x4 v[16];
#pragma unroll
    for (int i = 0; i < 16; ++i) v[i] = src ? *(const f32x4*)(src + (size_t)(k0 + 4 * i + rl) * ldw) : (f32x4){0.f, 0.f, 0.f, 0.f};
#pragma unroll
    for (int i = 0; i < 16; ++i) { const int kk = 4 * i + rl; const float g = gain ? gain[k0 + kk] : 1.0f;
        const unsigned p0 = cvt_pk_bf16(v[i][0] * g, v[i][1] * g), p1 = cvt_pk_bf16(v[i][2] * g, v[i][3] * g);
        T[(cg + 0) * 72 + kk] = (bf16_t)(p0 & 0xffffu); T[(cg + 1) * 72 + kk] = (bf16_t)(p0 >> 16);
        T[(cg + 2) * 72 + kk] = (bf16_t)(p1 & 0xffffu); T[(cg + 3) * 72 + kk] = (bf16_t)(p1 >> 16); }
    asm volatile("s_waitcnt lgkmcnt(0)" ::: "memory");
    const int c = lane & 7;
#pragma unroll
    for (int j = 0; j < 8; ++j) { const int n = (lane >> 3) + 8 * j;
        const u32x4 w = *(const LAS u32x4*)(T + n * 72 + 8 * c);
        *(u32x4*)(WT + (size_t)(n0 + n) * K + k0 + 8 * c) = w; }
    asm volatile("s_waitcnt lgkmcnt(0)" ::: "memory");
}
__device__ __forceinline__ void sincos_acc(float ang, float& s, float& c) {
    const double TWO_PI = 6.283185307179586476925286766559, INV = 0.15915494309189533576888376337251;
    const double a = (double)ang, k = __builtin_rint(a * INV); const float r = (float)(a - k * TWO_PI);
    s = sinf(r); c = cosf(r);
}
constexpr int I_GU = (DM / 64) * (2 * FF / 64), I_D = (FF / 64) * (DM / 64), I_EI = (DM / 64) * (EVEN_IN / 64), I_O = (DM / 64) * (DM / 64), I_OI = (DM / 64) * (ODD_INP / 64),
              I_Q = (256 / 64) * (768 / 64), I_KV = (256 / 64) * (1024 / 64);
constexpr int CI_P0 = I_GU, CI_A = CI_P0 + I_D + I_EI + I_O + I_GU + I_D, CI_B = CI_A + I_GU + I_D + I_OI + I_O + I_Q + I_KV, CI_C = CI_B + I_GU + I_D;
__device__ __forceinline__ void conv_gu(ArgsP A, unsigned char* ws, LAS bf16_t* scr, int w, int r, int lane) {
    const int l = w >> 1, f = w & 1, nblk = 2 * FF / 64, kb = r / nblk, nb = r % nblk;
    const float* wg = AIN(A, f ? I_F2G : I_F1G) + (size_t)l * DM * FF; const float* wu = AIN(A, f ? I_F2U : I_F1U) + (size_t)l * DM * FF;
    const float* gain = AIN(A, f ? I_F2N : I_F1N) + l * DM;
    conv_item(FF, DM, (bf16_t*)(ws + WS_WGU + (size_t)w * SZ_WGU), gain, scr, kb, nb, lane,
              [&](int n) -> const float* { const int t = n >> 8, q = n & 255; return (q < 128) ? (wg + 128 * t + q) : (wu + 128 * t + (q - 128)); });
}
__device__ __forceinline__ void conv_d(ArgsP A, unsigned char* ws, LAS bf16_t* scr, int w, int r, int lane) {
    const int l = w >> 1, f = w & 1, nblk = DM / 64, kb = r / nblk, nb = r % nblk;
    const float* wd = AIN(A, f ? I_F2D : I_F1D) + (size_t)l * FF * DM;
    conv_item(DM, FF, (bf16_t*)(ws + WS_WD + (size_t)w * SZ_WD), nullptr, scr, kb, nb, lane, [&](int n) -> const float* { return wd + n; });
}
__device__ __forceinline__ void conv_items(ArgsP A, LAS unsigned char* lds, int lo, int hi, int wi, int NW_, int wave, int lane) {
    unsigned char* ws = AWS(A);
    LAS bf16_t* scr = (LAS bf16_t*)(lds + wave * 9216);
    for (int it = lo + wi; it < hi; it += NW_) {
        int r = it;
        if (r < I_GU) { conv_gu(A, ws, scr, 0, r, lane); continue; } r -= I_GU;
        if (r < I_D) { conv_d(A, ws, scr, 0, r, lane); continue; } r -= I_D;
        if (r < I_EI) { const int nblk = EVEN_IN / 64, kb = r / nblk, nb = r % nblk; const float* w = AIN(A, I_EVIN); const float* gain = AIN(A, I_MIXN);
            conv_item(EVEN_IN, DM, (bf16_t*)(ws + WS_EVIN), gain, scr, kb, nb, lane,
                      [&](int n) -> const float* { if (n >= 1024) return w + n; const int c = n & 255, bj = c >> 7, wc = (c >> 5) & 3, ww = c & 31; return w + (n & ~255) + 64 * wc + 32 * bj + ww; });
            continue; }
        r -= I_EI;
        if (r < I_O) { const int nblk = DM / 64, kb = r / nblk, nb = r % nblk; const float* w = AIN(A, I_EVOUT);
            conv_item(DM, DM, (bf16_t*)(ws + WS_EVOUT), nullptr, scr, kb, nb, lane, [&](int n) -> const float* { return w + n; });
            continue; }
        r -= I_O;
        if (r < I_GU) { conv_gu(A, ws, scr, 1, r, lane); continue; } r -= I_GU;
        if (r < I_D) { conv_d(A, ws, scr, 1, r, lane); continue; } r -= I_D;
        if (r < I_GU) { conv_gu(A, ws, scr, 2, r, lane); continue; } r -= I_GU;
        if (r < I_D) { conv_d(A, ws, scr, 2, r, lane); continue; } r -= I_D;
        if (r < I_OI) { const int nblk = ODD_INP / 64, kb = r / nblk, nb = r % nblk; const float* w = AIN(A, I_ODIN); const float* gain = AIN(A, I_MIXN) + DM;
            conv_item(ODD_IN, DM, (bf16_t*)(ws + WS_ODIN), gain, scr, kb, nb, lane, [&](int n) -> const float* { return (n < ODD_IN) ? (w + n) : nullptr; });
            continue; }
        r -= I_OI;
        if (r < I_O) { const int nblk = DM / 64, kb = r / nblk, nb = r % nblk; const float* w = AIN(A, I_ODOUT);
            conv_item(DM, DM, (bf16_t*)(ws + WS_ODOUT), nullptr, scr, kb, nb, lane, [&](int n) -> const float* { return w + n; });
            continue; }
        r -= I_O;
        if (r < I_Q) { const int nblk = 768 / 64, kb = r / nblk, nb = r % nblk; const float* w = AIN(A, I_WUQ); const float* gain = AIN(A, I_GQ);
            conv_item(768, 256, (bf16_t*)(ws + WS_WUQ), gain, scr, kb, nb, lane,
                      [&](int n) -> const float* { if (n < 512) return w + (n >> 6) * 96 + (n & 63); const int c = n - 512, bj = c >> 7, wc = (c >> 5) & 3, ww = c & 31; return w + (2 * wc + (ww >> 4)) * 96 + 64 + 16 * bj + (ww & 15); });
            continue; }
        r -= I_Q;
        if (r < I_KV) { const int nblk = 1024 / 64, kb = r / nblk, nb = r % nblk; const float* w = AIN(A, I_WUKV); const bool real = kb < 2;
            conv_item(1024, 256, (bf16_t*)(ws + WS_WUKV), real ? AIN(A, I_GKV) : nullptr, scr, kb, nb, lane, [&](int n) -> const float* { return real ? (w + n) : nullptr; });
            continue; }
        r -= I_KV;
        if (r < I_GU) { conv_gu(A, ws, scr, 3, r, lane); continue; } r -= I_GU;
        conv_d(A, ws, scr, 3, r, lane);
    }
}
__device__ __forceinline__ void phase_p0(ArgsP A, LAS unsigned char* lds, int vcu, int G, int wave, int lane, int tid) {
    unsigned char* ws = AWS(A);
    const int gw = vcu * NWAVES + wave, NGW = G * NWAVES;
    conv_items(A, lds, 0, CI_P0, gw, NGW, wave, lane);
    { const int gt = vcu * (NWAVES * 64) + tid, NT_ = G * NWAVES * 64;
      float* cosA = (float*)(ws + WS_COSA); float* sinA = (float*)(ws + WS_SINA); float* cosD = (float*)(ws + WS_COSD); float* sinD = (float*)(ws + WS_SIND);
      for (int e = gt; e < SEQ * 32 + SEQ * 16; e += NT_) {
          int pos, i, dim; float* cp; float* sp;
          if (e < SEQ * 32) { pos = e >> 5; i = e & 31; dim = 64; cp = cosA + e; sp = sinA + e; } else { const int e2 = e - SEQ * 32; pos = e2 >> 4; i = e2 & 15; dim = 32; cp = cosD + e2; sp = sinD + e2; }
          const float inv = (float)(1.0 / exp2((double)(2 * i) / (double)dim * 13.287712379549449391481277717958));
          const float ang = (float)pos * inv; float s, c; sincos_acc(ang, s, c); *cp = c; *sp = s; }
      { float* spt = (float*)(ws + WS_SPT); for (int e = gt; e < 1024; e += NT_) spt[e] = log1pf(__expf(-AIN(A, I_RGLAM)[e])); }
      bf16_t* rgw = (bf16_t*)(ws + WS_RGW);
      for (int e = gt; e < 4 * 8 * 64 * 64; e += NT_) { const int k = e & 63, o = (e >> 6) & 63, n = (e >> 12) & 7, gd = e >> 15, dir = gd >> 1, gate = gd & 1;
          const float* src = AIN(A, gate ? I_RGWX : I_RGWA) + ((size_t)(dir * 8 + n) * 64 + k) * 64 + o; rgw[e] = (bf16_t)f2bf(*src); }
    }
    { const float* x = AIN(A, I_X); bf16_t* xb = (bf16_t*)(ws + WS_XB); float* ssq = (float*)(ws + WS_SSQ16);
      for (int m = gw; m < M; m += NGW) {
          const f32x4* xr = (const f32x4*)(x + (size_t)m * DM) + lane; f32x4 v[4]; float s = 0.f;
#pragma unroll
          for (int j = 0; j < 4; ++j) { v[j] = xr[64 * j]; s += (v[j].x * v[j].x + v[j].y * v[j].y) + (v[j].z * v[j].z + v[j].w * v[j].w); }
          s = wave_sum(s);
          u32x2* o8 = (u32x2*)(xb + (size_t)m * DM) + lane;
#pragma unroll
          for (int j = 0; j < 4; ++j) { u32x2 w; w.x = cvt_pk_bf16(v[j].x, v[j].y); w.y = cvt_pk_bf16(v[j].z, v[j].w); o8[64 * j] = w; }
          if (lane < 16) ssq[(size_t)m * 16 + lane] = (lane == 0) ? s : 0.f;
      } }
}

__device__ __forceinline__ void phase_final(ArgsP A, int vcu, int G, int wave, int lane) {
    float* out = AOUT(A); const float* g = AIN(A, I_FINN); const bf16_t* xb = (const bf16_t*)(AWS(A) + WS_XB); const float* ssq = (const float*)(AWS(A) + WS_SSQ16);
    f32x4 gv[4];
#pragma unroll
    for (int j = 0; j < 4; ++j) gv[j] = ((const f32x4*)g)[lane + 64 * j];
    const int gw = vcu * NWAVES + wave, NGW = G * NWAVES;
    for (int m = gw; m < M; m += NGW) {
        const u32x2* xr = (const u32x2*)(xb + (size_t)m * DM) + lane; u32x2 v[4];
#pragma unroll
        for (int j = 0; j < 4; ++j) v[j] = xr[64 * j];
        const float rs = rsqrtf(sum16(ssq + (size_t)m * 16) * (1.0f / DM) + RMS_EPS);
        f32x4* orow = (f32x4*)(out + (size_t)m * DM) + lane;
#pragma unroll
        for (int j = 0; j < 4; ++j) { const f32x4 x = {bf2f((bf16_t)(v[j].x & 0xffffu)), bf2f((bf16_t)(v[j].x >> 16)), bf2f((bf16_t)(v[j].y & 0xffffu)), bf2f((bf16_t)(v[j].y >> 16))};
            orow[64 * j] = x * rs * gv[j]; }
    }
}

__device__ __forceinline__ void phase_kpe(ArgsP A, int vcu, int G, int wave, int lane) {
    const bf16_t* OD = (const bf16_t*)(AWS(A) + WS_OD); bf16_t* Kf = (bf16_t*)(AWS(A) + WS_KF);
    const float* cosD = (const float*)(AWS(A) + WS_COSD); const float* sinD = (const float*)(AWS(A) + WS_SIND);
    const int gw = vcu * NWAVES + wave, NGW = G * NWAVES; const int d = 2 * (lane & 7), rr = lane >> 3;
    for (int m0 = 8 * gw; m0 < M; m0 += 8 * NGW) {
        const int m = m0 + rr, pos = m & (SEQ - 1);
        const unsigned xa = *(const unsigned*)(OD + (size_t)m * ODD_INP + 1408 + d), xb2 = *(const unsigned*)(OD + (size_t)m * ODD_INP + 1424 + d);
        const f32x2 c = *(const f32x2*)(cosD + pos * 16 + d), sn = *(const f32x2*)(sinD + pos * 16 + d);
        const float x1a = bf2f((bf16_t)(xa & 0xffffu)), x1b = bf2f((bf16_t)(xa >> 16)), x2a = bf2f((bf16_t)(xb2 & 0xffffu)), x2b = bf2f((bf16_t)(xb2 >> 16));
        const unsigned o1 = cvt_pk_bf16(x1a * c.x - x2a * sn.x, x1b * c.y - x2b * sn.y), o2 = cvt_pk_bf16(x1a * sn.x + x2a * c.x, x1b * sn.y + x2b * c.y);
        bf16_t* kp = Kf + (size_t)m * 768 + 64 + d;
#pragma unroll
        for (int h = 0; h < 8; ++h) { *(unsigned*)(kp + h * 96) = o1; *(unsigned*)(kp + h * 96 + 16) = o2; }
    }
}

constexpr int RG2_U = 0, RG2_G = 66560, RG2_GC = RG2_G + 33280, RG2_END = RG2_GC + 16640;
static_assert(RG2_END <= RING_BYTES, "rg lds");
template <int PASS>
__device__ __forceinline__ void rg_chunk(ArgsP A, LAS unsigned char* lds, int b, int j, int wave, int tid_in) {
    int tid = tid_in; asm volatile("" : "+v"(tid)); const int lane = tid & 63;
    const bf16_t* OD = (const bf16_t*)(AWS(A) + WS_OD); bf16_t* mix = (bf16_t*)(AWS(A) + WS_MIX); float* SUM = (float*)(AWS(A) + WS_SUM);
    const bf16_t* rgw = (const bf16_t*)(AWS(A) + WS_RGW); const float* spt = (const float*)(AWS(A) + WS_SPT);
    LAS bf16_t* U = (LAS bf16_t*)(lds + RG2_U); LAS bf16_t* G = (LAS bf16_t*)(lds + RG2_G); LAS bf16_t* GC = (LAS bf16_t*)(lds + RG2_GC);
    const size_t row0 = (size_t)b * SEQ + 64 * j;
    float cinf = 0.f, cinb = 0.f;
    if (PASS == 2) {
        const f32x2* Sf = (const f32x2*)SUM + ((size_t)b * 64 * 2 + 0) * 512 + tid;
        const f32x2* Sb = (const f32x2*)SUM + ((size_t)b * 64 * 2 + 1) * 512 + tid;
        float C = 0.f;
#pragma unroll 1
        for (int kb = 0; kb < 64; kb += 32) { if (kb >= j) break; f32x2 sv[32];
#pragma unroll
            for (int u = 0; u < 32; ++u) sv[u] = Sf[(size_t)(kb + u) * 1024];
#pragma unroll
            for (int u = 0; u < 32; ++u) C = (kb + u < j) ? sv[u].x * C + sv[u].y : C; }
        cinf = C; C = 0.f;
#pragma unroll 1
        for (int kb = 63; kb >= 0; kb -= 32) { if (kb <= j) break; f32x2 sv[32];
#pragma unroll
            for (int u = 0; u < 32; ++u) sv[u] = Sb[(size_t)(kb - u) * 1024];
#pragma unroll
            for (int u = 0; u < 32; ++u) C = (kb - u > j) ? sv[u].x * C + sv[u].y : C; }
        cinb = C;
    }
    {
        const int cp = tid & 255, th = tid >> 8, c0 = 2 * cp;
        const float* cw = AIN(A, I_CONVW);
        const f32x2 w0 = *(const f32x2*)(cw + c0), w1 = *(const f32x2*)(cw + 512 + c0), w2 = *(const f32x2*)(cw + 1024 + c0), w3 = *(const f32x2*)(cw + 1536 + c0), cb = *(const f32x2*)(AIN(A, I_CONVB) + c0);
        unsigned xr[35];
#pragma unroll
        for (int k = 0; k < 35; ++k) { const int tok = 64 * j + 32 * th - 1 + k; xr[k] = (tok >= 0 && tok < SEQ) ? *(const unsigned*)(OD + ((size_t)b * SEQ + tok) * ODD_INP + c0) : 0u; }
#pragma unroll
        for (int i = 0; i < 32; ++i) {
            const float ulo = w0.x * bf2f((bf16_t)(xr[i] & 0xffffu)) + w1.x * bf2f((bf16_t)(xr[i + 1] & 0xffffu)) + w2.x * bf2f((bf16_t)(xr[i + 2] & 0xffffu)) + w3.x * bf2f((bf16_t)(xr[i + 3] & 0xffffu)) + cb.x;
            const float uhi = w0.y * bf2f((bf16_t)(xr[i] >> 16)) + w1.y * bf2f((bf16_t)(xr[i + 1] >> 16)) + w2.y * bf2f((bf16_t)(xr[i + 2] >> 16)) + w3.y * bf2f((bf16_t)(xr[i + 3] >> 16)) + cb.y;
            *(LAS unsigned*)(U + (32 * th + i) * 520 + c0) = cvt_pk_bf16(ulo, uhi); }
    }
    __syncthreads();
    const int n = wave, fr = lane & 15, kg = lane >> 4;
    float hf[64];
#pragma unroll
    for (int d = 0; d < 2; ++d) {
        bf16x8 bw[2][4][2]; float bs[2][4];
#pragma unroll
        for (int gate = 0; gate < 2; ++gate)
#pragma unroll
            for (int ot = 0; ot < 4; ++ot) { bs[gate][ot] = AIN(A, gate ? I_RGBX : I_RGBA)[d * 512 + n * 64 + 16 * ot + fr];
#pragma unroll
                for (int ks = 0; ks < 2; ++ks) bw[gate][ot][ks] = *(const bf16x8*)(rgw + (((size_t)(2 * d + gate) * 8 + n) * 64 + 16 * ot + fr) * 64 + 32 * ks + 8 * kg); }
        const float kk = -8.0f * LOG2E * spt[d * 512 + tid];
        float h = (PASS == 2) ? (d == 0 ? cinf : cinb) : 0.f, Atot = 1.f;
#pragma unroll
        for (int qq = 0; qq < 4; ++qq) { const int q = (d == 0) ? qq : 3 - qq;
            u32x4 gcr[2];
            if (PASS == 2 && d == 1) {
#pragma unroll
                for (int i = 0; i < 2; ++i) { const int c = tid + 512 * i; gcr[i] = *(const u32x4*)(OD + (row0 + 16 * q + (c >> 6)) * ODD_INP + 512 + 8 * (c & 63)); } }
            bf16x8 af[2];
#pragma unroll
            for (int ks = 0; ks < 2; ++ks) af[ks] = *(const LAS bf16x8*)(U + (16 * q + fr) * 520 + n * 64 + 32 * ks + 8 * kg);
#pragma unroll
            for (int gate = 0; gate < 2; ++gate)
#pragma unroll
                for (int ot = 0; ot < 4; ++ot) {
                    f32x4 dd = (f32x4){0.f, 0.f, 0.f, 0.f};
                    dd = MFMA16(af[0], bw[gate][ot][0], dd);
                    dd = MFMA16(af[1], bw[gate][ot][1], dd);
#pragma unroll
                    for (int e = 0; e < 4; ++e) G[(gate * 16 + 4 * kg + e) * 520 + n * 64 + 16 * ot + fr] = (bf16_t)f2bf(fast_sigmoid(dd[e] + bs[gate][ot]));
                }
            if (PASS == 2 && d == 1) {
#pragma unroll
                for (int i = 0; i < 2; ++i) { const int c = tid + 512 * i; *(LAS u32x4*)(GC + (c >> 6) * 520 + 8 * (c & 63)) = gcr[i]; } }
            __syncthreads();
#pragma unroll
            for (int i = 0; i < 16; ++i) { const int tl = (d == 0) ? i : 15 - i, tok = 16 * q + tl;
                const float u = bf2f(U[tok * 520 + tid]), r = bf2f(G[tl * 520 + tid]), ig = bf2f(G[(16 + tl) * 520 + tid]);
                const float a = __builtin_amdgcn_exp2f(kk * r);
                float mult = __builtin_amdgcn_sqrtf(fmaxf(1.0f - a * a, 0.f));
                if (d == 0 && tok == 0) mult = (j == 0) ? 1.0f : mult;
                if (d == 1 && tok == 63) mult = (j == 63) ? 1.0f : mult;
                h = a * h + mult * ig * u;
                if (PASS == 1) Atot *= a;
                if (PASS == 2) {
                    if (d == 0) hf[tok] = h;
                    else { const float gc = bf2f(GC[tl * 520 + tid]);
                        const float y = 0.7978845608028654f * (gc + 0.044715f * gc * gc * gc); const float th2 = 1.0f - 2.0f * __builtin_amdgcn_rcpf(__builtin_amdgcn_exp2f(2.0f * LOG2E * y) + 1.0f);
                        U[tok * 520 + tid] = (bf16_t)f2bf(0.5f * gc * (1.0f + th2) * (hf[tok] + h)); } } }
            __syncthreads();
        }
        if (PASS == 1) *(f32x2*)(SUM + ((((size_t)b * 64 + j) * 2 + d) * 512 + tid) * 2) = (f32x2){Atot, h};
    }
    if (PASS == 2) {
#pragma unroll
        for (int i = 0; i < 8; ++i) { const int c = tid + 512 * i, row = c >> 6, ch8 = (c & 63) * 8;
            const u32x4 v = *(const LAS u32x4*)(U + row * 520 + ch8);
            *(u32x4*)(mix + (row0 + row) * 1024 + ch8) = v; }
    }
    __syncthreads();
}

constexpr int NSTEP = 23;
#ifndef PH_MASK
#define PH_MASK 0x7fffff
#endif
#define S_ON(k) (((PH_MASK) >> (k)) & 1)
#ifndef DUP_MASK
#define DUP_MASK 0x0
#endif
#define STEP_BEGIN(k) if (S_ON(k) && ph_lo <= (k) && (k) < ph_hi) { const int nrep_ = 1 + (((DUP_MASK) >> (k)) & 1); for (int rep_ = 0; rep_ < nrep_; ++rep_) { \
        int tid = wave_s * 64 + (int)__builtin_amdgcn_mbcnt_hi(~0u, __builtin_amdgcn_mbcnt_lo(~0u, 0u)); asm volatile("" : "+v"(tid)); \
        int bx = blockIdx.x; asm volatile("" : "+s"(bx)); \
        ArgsP args = (ArgsP)__builtin_amdgcn_kernarg_segment_ptr(); asm volatile("" : "+s"(args)); \
        const int lane = tid & 63, wave = __builtin_amdgcn_readfirstlane(tid >> 6); \
        const int G = gridDim.x, vcu = (G % 8 == 0) ? (bx % 8) * (G / 8) + bx / 8 : bx; \
        unsigned char* ws = AWS(args); (void)lane; (void)wave; (void)vcu; (void)ws;
#define STEP_END(k, BAR) if ((k) + 1 < ph_hi || rep_ + 1 < nrep_) { if (BAR) xcd_barrier(bar, tid == 0); else __syncthreads(); } } }

#define DO_UP(par) do { pg8::Gemm g{(const bf16_t*)(ws + WS_XB), (const bf16_t*)(ws + WS_WGU + (size_t)(par) * SZ_WGU), DM, 2 * FF, DM}; pg8::StaticOrder S; S.init(M, 2 * FF, G, bx); \
        pg8::EpiSwiglu E{(bf16_t*)(ws + WS_H), (const float*)(ws + WS_SSQ16)}; pg8::gemm_phase(lds, g, S, E, pg8::RsSpec{(const float*)(ws + WS_SSQ16), 16, 1.0f / DM}, tid); } while (0)
#define DO_TAIL(lo_, hi_) do { const int nU_ = (M / 256) * (2 * FF / 256), nfull_ = nU_ % G; \
        if (nfull_ != 0 && bx >= nfull_) conv_items(args, lds, (lo_), (hi_), (bx - nfull_) * NWAVES + wave, (G - nfull_) * NWAVES, wave, lane); \
        else if (nfull_ == 0) conv_items(args, lds, (lo_), (hi_), bx * NWAVES + wave, G * NWAVES, wave, lane); } while (0)
#define DO_DOWN(par) do { pg8::Gemm g{(const bf16_t*)(ws + WS_H), (const bf16_t*)(ws + WS_WD + (size_t)(par) * SZ_WD), FF, DM, FF}; pg8::StaticOrder S; S.init(M, DM, G, bx); \
        pg8::EpiResid E{(bf16_t*)(ws + WS_XB), (float*)(ws + WS_SSQ16), (rep_ + 1 < nrep_) ? 0.0f : 0.5f}; pg8::gemm_phase(lds, g, S, E, pg8::RsSpec{nullptr, 0, 0.f}, tid); } while (0)
#define DO_OUT(par) do { pg8::Gemm g{(const bf16_t*)(ws + WS_MIX), (const bf16_t*)(ws + ((par) == 0 ? WS_EVOUT : WS_ODOUT)), DM, DM, DM}; pg8::StaticOrder S; S.init(M, DM, G, bx); \
        pg8::EpiResid E{(bf16_t*)(ws + WS_XB), (float*)(ws + WS_SSQ16), (rep_ + 1 < nrep_) ? 0.0f : 1.0f}; pg8::gemm_phase(lds, g, S, E, pg8::RsSpec{nullptr, 0, 0.f}, tid); } while (0)

__global__ void __launch_bounds__(NWAVES * 64, 2) mk_fwd(Args args_k) {
    extern __shared__ __attribute__((aligned(16))) unsigned char lds_raw[];
    LAS unsigned char* lds = (LAS unsigned char*)lds_raw;
    volatile LAS unsigned* MISC = (volatile LAS unsigned*)(lds + MISC_OFF);
    const int t0_ = threadIdx.x;
    const int wave_s = __builtin_amdgcn_readfirstlane(t0_ >> 6);
    for (int u = t0_; u < (LDS_BYTES - LDSCTL_OFF) / 4; u += NWAVES * 64) ((LAS unsigned*)(lds + LDSCTL_OFF))[u] = 0u;
    __syncthreads();
    XcdBarrier bar; bar.bar = (unsigned*)((unsigned char*)(GAS unsigned char*)args_k.ws + WS_CTL) + 4096; bar.x = 0; bar.st = nullptr;
    const int ph_lo = args_k.ph_lo, ph_hi = args_k.ph_hi;
    if (ph_hi - ph_lo > 1) bar = xcd_barrier_post((unsigned*)((unsigned char*)(GAS unsigned char*)args_k.ws + WS_CTL) + 4096, MISC + 8, t0_ == 0);

    STEP_BEGIN(0) phase_p0(args, lds, vcu, G, wave, lane, tid); STEP_END(0, true)
    STEP_BEGIN(1) DO_UP(0); DO_TAIL(CI_P0, CI_A); STEP_END(1, true)
    STEP_BEGIN(2) DO_DOWN(0); STEP_END(2, true)
    STEP_BEGIN(3) {
        pg8::Gemm g{(const bf16_t*)(ws + WS_XB), (const bf16_t*)(ws + WS_EVIN), DM, EVEN_IN, DM}; pg8::StaticOrder S; S.init(M, EVEN_IN, G, bx);
        pg8::EpiInEven E{(bf16_t*)(ws + WS_QKV), (const float*)(ws + WS_SSQ16), (const float*)(ws + WS_COSA), (const float*)(ws + WS_SINA)};
        pg8::gemm_phase(lds, g, S, E, pg8::RsSpec{(const float*)(ws + WS_SSQ16), 16, 1.0f / DM}, tid); } STEP_END(3, true)
    STEP_BEGIN(4) {
        const bf16_t* QKV = (const bf16_t*)(ws + WS_QKV); bf16_t* MIX = (bf16_t*)(ws + WS_MIX); float* SC = AOUT(args);
        const float* lf = AIN(args, I_DLAM);
        const float s1 = wave_sum(lf[lane] * lf[64 + lane]), s2 = wave_sum(lf[128 + lane] * lf[192 + lane]);
        const float lam = __expf(s1) - __expf(s2) + 0.2f;
#pragma unroll 1
        for (int ud = vcu; ud < 256; ud += G) { const int qb = ud & 15, h = (ud >> 4) & 3, b = ud >> 6;
            const size_t r0 = (size_t)b * SEQ;
            att::NAArgs na{0, nullptr};
            att::DiffArgs da{SC + (r0 + 256 * qb) * 512 + h * 128, lam, AIN(args, I_DSUB)};
            att::attn_unit<64, 128, false, 1>(QKV + (r0 + 256 * qb) * EVEN_IN + (2 * h) * 64, EVEN_IN, QKV + r0 * EVEN_IN + 512 + (2 * h) * 64, EVEN_IN, QKV + r0 * EVEN_IN + 1024 + h * 128, EVEN_IN,
                                              MIX + (r0 + 256 * qb) * 1024 + h * 128, 1024, 0, SEQ / 64, (LAS char*)lds, na, da, tid);
            att::attn_unit<64, 128, false, 2>(QKV + (r0 + 256 * qb) * EVEN_IN + (2 * h + 1) * 64, EVEN_IN, QKV + r0 * EVEN_IN + 512 + (2 * h + 1) * 64, EVEN_IN, QKV + r0 * EVEN_IN + 1024 + h * 128, EVEN_IN,
                                              MIX + (r0 + 256 * qb) * 1024 + h * 128, 1024, 0, SEQ / 64, (LAS char*)lds, na, da, tid); } } STEP_END(4, false)
    STEP_BEGIN(5) {
        const bf16_t* QKV = (const bf16_t*)(ws + WS_QKV); bf16_t* MIX = (bf16_t*)(ws + WS_MIX);
#pragma unroll 1
        for (int un0 = 2 * vcu; un0 < 512; un0 += 2 * G) for (int i = 0; i < 2; ++i) { const int un = un0 + i; const int qb = un & 15, h = (un >> 4) & 7, b = un >> 7;
            const size_t r0 = (size_t)b * SEQ;
            LAS float* rpbL = (LAS float*)(lds + att::Geo<64, 64>::RPBOFF);
            const float* rpb = AIN(args, I_RPB) + h * 465;
            for (int e = tid; e < 465; e += NWAVES * 64) rpbL[e] = rpb[e] * LOG2E;
            const int tlo = max(0, 4 * qb - 4), thi = min(64, 4 * qb + 8);
            att::NAArgs na{qb, rpbL};
            att::attn_unit<64, 64, true, 0>(QKV + (r0 + 256 * qb) * EVEN_IN + 1536 + h * 64, EVEN_IN, QKV + r0 * EVEN_IN + 2048 + h * 64, EVEN_IN, QKV + r0 * EVEN_IN + 2560 + h * 64, EVEN_IN,
                                         MIX + (r0 + 256 * qb) * 1024 + 512 + h * 64, 1024, tlo, thi - tlo, (LAS char*)lds, na, att::DiffArgs{nullptr, 0.f, nullptr}, tid); } } STEP_END(5, true)
    STEP_BEGIN(7) DO_OUT(0); STEP_END(7, true)
    STEP_BEGIN(8) DO_UP(1); DO_TAIL(CI_A, CI_B); STEP_END(8, true)
    STEP_BEGIN(9) DO_DOWN(1); STEP_END(9, true)
    STEP_BEGIN(10) DO_UP(2); DO_TAIL(CI_B, CI_C); STEP_END(10, true)
    STEP_BEGIN(11) DO_DOWN(2); STEP_END(11, true)
    STEP_BEGIN(12) {
        pg8::Gemm g{(const bf16_t*)(ws + WS_XB), (const bf16_t*)(ws + WS_ODIN), DM, ODD_INP, DM}; pg8::StaticOrder S; S.init(M, ODD_INP, G, bx);
        pg8::EpiInOdd E{(bf16_t*)(ws + WS_OD), (const float*)(ws + WS_SSQ16), (float*)(ws + WS_SSQCQ), (float*)(ws + WS_SSQCKV)};
        pg8::gemm_phase(lds, g, S, E, pg8::RsSpec{(const float*)(ws + WS_SSQ16), 16, 1.0f / DM}, tid); } STEP_END(12, true)
    STEP_BEGIN(13) {
#pragma unroll 1
        for (int uc = vcu; uc < 256; uc += G) rg_chunk<1>(args, lds, uc >> 6, uc & 63, wave, tid); } STEP_END(13, false)
    STEP_BEGIN(14) phase_kpe(args, vcu, G, wave, lane); STEP_END(14, false)
    STEP_BEGIN(15) {
        pg8::Gemm g{(const bf16_t*)(ws + WS_OD) + 1024, (const bf16_t*)(ws + WS_WUQ), ODD_INP, 768, 256}; pg8::StaticOrder S; S.init(M, 768, G, bx);
        pg8::EpiQup E{(bf16_t*)AOUT(args), (const float*)(ws + WS_SSQCQ), (const float*)(ws + WS_COSD), (const float*)(ws + WS_SIND)};
        pg8::gemm_phase(lds, g, S, E, pg8::RsSpec{(const float*)(ws + WS_SSQCQ), 4, 1.0f / 256.0f}, tid); } STEP_END(15, false)
    STEP_BEGIN(16) {
        pg8::Gemm g{(const bf16_t*)(ws + WS_OD) + 1280, (const bf16_t*)(ws + WS_WUKV), ODD_INP, 1024, 256}; pg8::StaticOrder S; S.init(M, 1024, G, bx);
        pg8::EpiKVup E{(bf16_t*)(ws + WS_KF), (bf16_t*)(ws + WS_VM), (const float*)(ws + WS_SSQCKV)};
        pg8::gemm_phase(lds, g, S, E, pg8::RsSpec{(const float*)(ws + WS_SSQCKV), 4, 1.0f / 128.0f}, tid); } STEP_END(16, true)
    STEP_BEGIN(17) {
#pragma unroll 1
        for (int uc = vcu; uc < 256; uc += G) rg_chunk<2>(args, lds, uc >> 6, uc & 63, wave, tid); } STEP_END(17, false)
    STEP_BEGIN(18) {
        const bf16_t* QM = (const bf16_t*)AOUT(args);   const bf16_t* KF = (const bf16_t*)(ws + WS_KF); const bf16_t* VM = (const bf16_t*)(ws + WS_VM); bf16_t* MIX = (bf16_t*)(ws + WS_MIX);
#pragma unroll 1
        for (int um0 = 2 * vcu; um0 < 512; um0 += 2 * G) for (int i = 0; i < 2; ++i) { const int um = um0 + i; const int qb = um & 15, h = (um >> 4) & 7, b = um >> 7;
            const size_t r0 = (size_t)b * SEQ;
            att::NAArgs na{0, nullptr};
            att::attn_unit<96, 64, false, 0>(QM + (r0 + 256 * qb) * 768 + h * 96, 768, KF + r0 * 768 + h * 96, 768, VM + r0 * 512 + h * 64, 512,
                                          MIX + (r0 + 256 * qb) * 1024 + 512 + h * 64, 1024, 0, SEQ / 64, (LAS char*)lds, na, att::DiffArgs{nullptr, 0.f, nullptr}, tid); } } STEP_END(18, true)
    STEP_BEGIN(19) DO_OUT(1); STEP_END(19, true)
    STEP_BEGIN(20) DO_UP(3); STEP_END(20, true)
    STEP_BEGIN(21) DO_DOWN(3); STEP_END(21, true)
    STEP_BEGIN(22) phase_final(args, vcu, G, wave, lane); STEP_END(22, false)
}

extern "C" void kernel_launch(void* const* d_in, const int* in_sizes, int n_in, void* d_out, int out_size, void* d_ws, size_t ws_size, hipStream_t stream) {
    static int grid = 0;
    if (grid == 0) {
        if (n_in != 29 || in_sizes[0] != M * DM || out_size != M * DM || ws_size < WS_END) {
            fprintf(stderr, "kernel_launch: unexpected shapes: n_in %d in0 %d out %d ws %zu (need %zu)\n", n_in, n_in > 0 ? in_sizes[0] : -1, out_size, ws_size, (size_t)WS_END); grid = -1; return; }
        int dev = 0, cus = 0;
        if (hipGetDevice(&dev) != hipSuccess || hipDeviceGetAttribute(&cus, hipDeviceAttributeMultiprocessorCount, dev) != hipSuccess) { fprintf(stderr, "kernel_launch: device query failed\n"); grid = -1; return; }
        if (hipFuncSetAttribute((const void*)mk_fwd, hipFuncAttributeMaxDynamicSharedMemorySize, LDS_BYTES) != hipSuccess) { fprintf(stderr, "kernel_launch: hipFuncSetAttribute failed\n"); grid = -1; return; }
        int per_cu = 0;
        if (hipOccupancyMaxActiveBlocksPerMultiprocessor(&per_cu, (const void*)mk_fwd, NWAVES * 64, LDS_BYTES) != hipSuccess || per_cu < 1)
            fprintf(stderr, "kernel_launch: note: occupancy query reports %d workgroups per CU\n", per_cu);
        (void)hipGetLastError();
        grid = cus;
        if (grid != 256) fprintf(stderr, "kernel_launch: note: %d CUs\n", grid);
    }
    if (grid < 0) return;
    (void)hipMemsetAsync((char*)d_ws + WS_CTL, 0, CTL_ZERO_BYTES, stream);
    Args a{};
    for (int i = 0; i < 29; ++i) a.in[i] = (const float*)d_in[i];
    a.out = (float*)d_out; a.ws = (unsigned char*)d_ws;
#if MK_ONE_LAUNCH
    a.ph_lo = 0; a.ph_hi = NSTEP;
    hipLaunchKernelGGL(mk_fwd, dim3(grid), dim3(NWAVES * 64), LDS_BYTES, stream, a);
#else
    for (int ph = 0; ph < NSTEP; ++ph) { a.ph_lo = ph; a.ph_hi = ph + 1; hipLaunchKernelGGL(mk_fwd, dim3(grid), dim3(NWAVES * 64), LDS_BYTES, stream, a); }
#endif
    const hipError_t le = hipPeekAtLastError();
    if (le != hipSuccess) fprintf(stderr, "kernel_launch: launch failed: %s\n", hipGetErrorName(le));
}
```
